# Optimizing an MI355X kernel written in HIP

```python
import math
import jax, jax.numpy as jnp
from jax import lax
import numpy as np

D_MODEL = 1024
BATCH = 16
SEQ = 256
DEPTH = 2
DEC_BATCH = 2
DEC_SEQ = 2048
PAST_LEN = 512

GRID_W = 64
N_MIXERS = 2
N_DIFF_LAYERS = (DEPTH + 1) // 2
N_SWA_LAYERS = DEPTH // 2
DIFF_HEADS = 8
DIFF_HD = 64
SWA_HEADS = 16
SWA_KV_HEADS = 4
SWA_GROUP = SWA_HEADS // SWA_KV_HEADS
SWA_HD = 64
ROT_DIM = 64
WINDOW = 128
BLOCK = 128
D_FF = -(-8 * D_MODEL // (3 * 256)) * 256
D_QKV_DIFF = 3 * DIFF_HEADS * 2 * DIFF_HD
D_QKV_SWA = (SWA_HEADS + 2 * SWA_KV_HEADS) * SWA_HD
ROPE_BASE = 10000.0
EPS = 1e-6
NEG_INF = -1e30

kernel_name = "hybrid_diff_swa_dit_step"


def rmsnorm(x, g):
    xf = x.astype(jnp.float32)
    y = xf * lax.rsqrt(jnp.mean(xf * xf, axis=-1, keepdims=True) + EPS)
    return (y * g.astype(jnp.float32)).astype(x.dtype)


def modulation(cond, w_mod, b_mod):
    m = jax.nn.silu(cond) @ w_mod + b_mod
    return jnp.split(m[:, None, :], 6, axis=-1)


def pre_norm_modulate(x, g, shift, scale):
    return rmsnorm(x, g) * (1 + scale) + shift


def post_norm_residual(x, y, g, gate):
    return x + gate * rmsnorm(y, g)


def swiglu(h, w_gate, w_up, w_down):
    return (jax.nn.silu(h @ w_gate) * (h @ w_up)) @ w_down


def axial_rope_tables(n_lat, rot_dim):
    rows = n_lat // GRID_W
    t = jnp.arange(rows * GRID_W)
    row = (t // GRID_W).astype(jnp.float32)
    col = (t % GRID_W).astype(jnp.float32)
    nf = rot_dim // 4
    inv = ROPE_BASE ** (-jnp.arange(nf, dtype=jnp.float32) / nf)
    ar = row[:, None] * inv[None, :]
    ac = col[:, None] * inv[None, :]
    ang = jnp.concatenate([ar, ar, ac, ac], axis=-1)
    return jnp.cos(ang), jnp.sin(ang)


def apply_axial_rope(x, cos, sin):
    x1, x2, x3, x4 = jnp.split(x, 4, axis=-1)
    rot = jnp.concatenate([-x2, x1, -x4, x3], axis=-1)
    shape = (1, x.shape[1]) + (1,) * (x.ndim - 3) + (x.shape[-1],)
    out = x.astype(jnp.float32) * cos.reshape(shape) + rot.astype(jnp.float32) * sin.reshape(shape)
    return out.astype(x.dtype)


def diff_lambda_value(lam_params, lam_init):
    lp = lam_params.astype(jnp.float32)
    return jnp.exp(jnp.sum(lp[0] * lp[1])) - jnp.exp(jnp.sum(lp[2] * lp[3])) + lam_init


def diff_project(h, w_qkv):
    B, L, _ = h.shape
    q, k, v = jnp.split(h @ w_qkv, 3, axis=-1)
    q = q.reshape(B, L, DIFF_HEADS, 2, DIFF_HD)
    k = k.reshape(B, L, DIFF_HEADS, 2, DIFF_HD)
    v = v.reshape(B, L, DIFF_HEADS, 2 * DIFF_HD)
    return q, k, v


def diff_block_attention(q, k, v, lam):
    B, Lq = q.shape[:2]
    nb = Lq // BLOCK
    scale = DIFF_HD ** -0.5
    qb = q.reshape(B, nb, BLOCK, DIFF_HEADS, 2, DIFF_HD).swapaxes(0, 1)

    def one_block(qi):
        s = jnp.einsum('bqhmd,bkhmd->bhmqk', qi, k).astype(jnp.float32) * scale
        p = jax.nn.softmax(s, axis=-1)
        a = p[:, :, 0] - lam * p[:, :, 1]
        return jnp.einsum('bhqk,bkhe->bqhe', a.astype(v.dtype), v)

    out = lax.map(one_block, qb)
    return out.swapaxes(0, 1).reshape(B, Lq, DIFF_HEADS, 2 * DIFF_HD)


def diff_output(o, subln_g, lam_init, w_o):
    B, L = o.shape[:2]
    o = rmsnorm(o, subln_g) * (1.0 - lam_init)
    return o.reshape(B, L, DIFF_HEADS * 2 * DIFF_HD) @ w_o


def swa_project(h, w_qkv):
    B, L, _ = h.shape
    nq = SWA_HEADS * SWA_HD
    nkv = SWA_KV_HEADS * SWA_HD
    qkv = h @ w_qkv
    q = qkv[..., :nq].reshape(B, L, SWA_KV_HEADS, SWA_GROUP, SWA_HD)
    k = qkv[..., nq:nq + nkv].reshape(B, L, SWA_KV_HEADS, SWA_HD)
    v = qkv[..., nq + nkv:].reshape(B, L, SWA_KV_HEADS, SWA_HD)
    return q, k, v


def sink_softmax(s, sink):
    sk = sink.astype(jnp.float32).reshape(SWA_KV_HEADS, SWA_GROUP)[None, :, :, None, None]
    m = jnp.maximum(jnp.max(s, axis=-1, keepdims=True), sk)
    e = jnp.exp(s - m)
    return e / (jnp.sum(e, axis=-1, keepdims=True) + jnp.exp(sk - m))


def swa_context_attention(q, k, v, sink):
    B, Lq = q.shape[:2]
    nb = Lq // BLOCK
    scale = SWA_HD ** -0.5
    qb = q.reshape(B, nb, BLOCK, SWA_KV_HEADS, SWA_GROUP, SWA_HD).swapaxes(0, 1)

    def one_block(qi):
        s = jnp.einsum('bqkgd,bjkd->bkgqj', qi, k).astype(jnp.float32) * scale
        p = sink_softmax(s, sink)
        return jnp.einsum('bkgqj,bjkd->bqkgd', p.astype(v.dtype), v)

    out = lax.map(one_block, qb)
    return out.swapaxes(0, 1).reshape(B, Lq, SWA_HEADS * SWA_HD)


def swa_latent_attention(q, k, v, k_ctx, v_ctx, sink):
    B, L = q.shape[:2]
    nb = L // BLOCK
    Lc = k_ctx.shape[1]
    span = BLOCK + 2 * WINDOW
    scale = SWA_HD ** -0.5
    pad = ((0, 0), (WINDOW, WINDOW), (0, 0), (0, 0))
    kp = jnp.pad(k, pad)
    vp = jnp.pad(v, pad)
    qb = q.reshape(B, nb, BLOCK, SWA_KV_HEADS, SWA_GROUP, SWA_HD).swapaxes(0, 1)

    def one_block(args):
        qi, i = args
        start = i * BLOCK
        kn = lax.dynamic_slice_in_dim(kp, start, span, axis=1)
        vn = lax.dynamic_slice_in_dim(vp, start, span, axis=1)
        q_pos = start + jnp.arange(BLOCK)
        k_pos = start - WINDOW + jnp.arange(span)
        valid = ((k_pos[None, :] >= 0) & (k_pos[None, :] < L)
                 & (jnp.abs(q_pos[:, None] - k_pos[None, :]) <= WINDOW))
        s_lat = jnp.einsum('bqkgd,bjkd->bkgqj', qi, kn).astype(jnp.float32) * scale
        s_lat = jnp.where(valid, s_lat, NEG_INF)
        s_ctx = jnp.einsum('bqkgd,bjkd->bkgqj', qi, k_ctx).astype(jnp.float32) * scale
        p = sink_softmax(jnp.concatenate([s_ctx, s_lat], axis=-1), sink).astype(v.dtype)
        return (jnp.einsum('bkgqj,bjkd->bqkgd', p[..., :Lc], v_ctx)
                + jnp.einsum('bkgqj,bjkd->bqkgd', p[..., Lc:], vn))

    out = lax.map(one_block, (qb, jnp.arange(nb)))
    return out.swapaxes(0, 1).reshape(B, L, SWA_HEADS * SWA_HD)


def setup_inputs(seed: int = 0) -> dict:
    key = jax.random.key(seed)
    ks = jax.random.split(key, 24)
    f32 = jnp.float32
    n = lambda k, s: jax.random.normal(k, s, f32)
    D = D_MODEL
    return {
        "x_prompt": n(ks[0], (BATCH, SEQ, D)),
        "x_sample": n(ks[1], (DEC_BATCH, DEC_SEQ, D)),
        "cache_diff_k": n(ks[2], (DEC_BATCH, N_DIFF_LAYERS, PAST_LEN, DIFF_HEADS, 2 * DIFF_HD)),
        "cache_diff_v": n(ks[3], (DEC_BATCH, N_DIFF_LAYERS, PAST_LEN, DIFF_HEADS, 2 * DIFF_HD)),
        "cache_swa_k": n(ks[4], (DEC_BATCH, N_SWA_LAYERS, PAST_LEN, SWA_KV_HEADS, SWA_HD)),
        "cache_swa_v": n(ks[5], (DEC_BATCH, N_SWA_LAYERS, PAST_LEN, SWA_KV_HEADS, SWA_HD)),
        "c": n(ks[6], (DEC_BATCH, D)),
        "c_ctx": n(ks[7], (D,)),
        "w_mod": n(ks[8], (DEPTH, D, 6 * D)) * (0.5 * D ** -0.5),
        "b_mod": n(ks[9], (DEPTH, 6 * D)) * 0.01,
        "norm_g": 1.0 + 0.05 * n(ks[10], (DEPTH, 4, D)),
        "w_qkv_diff": n(ks[11], (N_DIFF_LAYERS, D, D_QKV_DIFF)) * D ** -0.5,
        "diff_lambda": n(ks[12], (N_DIFF_LAYERS, 4, DIFF_HD)) * 0.1,
        "diff_subln_g": 1.0 + 0.05 * n(ks[13], (N_DIFF_LAYERS, 2 * DIFF_HD)),
        "w_o_diff": n(ks[14], (N_DIFF_LAYERS, DIFF_HEADS * 2 * DIFF_HD, D)) * (DIFF_HEADS * 2 * DIFF_HD) ** -0.5,
        "w_qkv_swa": n(ks[15], (N_SWA_LAYERS, D, D_QKV_SWA)) * D ** -0.5,
        "swa_sink": n(ks[16], (N_SWA_LAYERS, SWA_HEADS)) * 0.5,
        "w_o_swa": n(ks[17], (N_SWA_LAYERS, SWA_HEADS * SWA_HD, D)) * (SWA_HEADS * SWA_HD) ** -0.5,
        "w_gate": n(ks[18], (DEPTH, D, D_FF)) * D ** -0.5,
        "w_up": n(ks[19], (DEPTH, D, D_FF)) * D ** -0.5,
        "w_down": n(ks[20], (DEPTH, D_FF, D)) * D_FF ** -0.5,
    }


def reference(x_prompt, x_sample, cache_diff_k, cache_diff_v, cache_swa_k, cache_swa_v, c, c_ctx,
              w_mod, b_mod, norm_g, w_qkv_diff, diff_lambda, diff_subln_g, w_o_diff,
              w_qkv_swa, swa_sink, w_o_swa, w_gate, w_up, w_down):
    Bp, Lp = x_prompt.shape[:2]
    Bs, Ls = x_sample.shape[:2]
    Lc = cache_diff_k.shape[2]
    cos, sin = axial_rope_tables(Ls, ROT_DIM)
    xp, xs = x_prompt, x_sample
    diff_k_out, diff_v_out, swa_k_out, swa_v_out = [], [], [], []

    for i in range(DEPTH):
        mp = modulation(c_ctx[None, :], w_mod[i], b_mod[i])
        ms = modulation(c, w_mod[i], b_mod[i])
        hp = pre_norm_modulate(xp, norm_g[i, 0], mp[0], mp[1])
        hs = pre_norm_modulate(xs, norm_g[i, 0], ms[0], ms[1])
        j = i // N_MIXERS
        if i % N_MIXERS == 0:
            lam_init = 0.8 - 0.6 * math.exp(-0.3 * i)
            lam = diff_lambda_value(diff_lambda[j], lam_init)
            qp, kp, vp = diff_project(hp, w_qkv_diff[j])
            yp = diff_output(diff_block_attention(qp, kp, vp, lam), diff_subln_g[j], lam_init, w_o_diff[j])
            diff_k_out.append(kp.reshape(Bp, Lp, DIFF_HEADS, 2 * DIFF_HD))
            diff_v_out.append(vp)
            qs, ks_, vs = diff_project(hs, w_qkv_diff[j])
            qs = apply_axial_rope(qs, cos, sin)
            ks_ = apply_axial_rope(ks_, cos, sin)
            kc = cache_diff_k[:, j].reshape(Bs, Lc, DIFF_HEADS, 2, DIFF_HD)
            k_all = jnp.concatenate([kc, ks_], axis=1)
            v_all = jnp.concatenate([cache_diff_v[:, j], vs], axis=1)
            ys = diff_output(diff_block_attention(qs, k_all, v_all, lam), diff_subln_g[j], lam_init, w_o_diff[j])
        else:
            qp, kp, vp = swa_project(hp, w_qkv_swa[j])
            yp = swa_context_attention(qp, kp, vp, swa_sink[j]) @ w_o_swa[j]
            swa_k_out.append(kp)
            swa_v_out.append(vp)
            qs, ks_, vs = swa_project(hs, w_qkv_swa[j])
            qs = apply_axial_rope(qs, cos, sin)
            ks_ = apply_axial_rope(ks_, cos, sin)
            ys = swa_latent_attention(qs, ks_, vs, cache_swa_k[:, j], cache_swa_v[:, j], swa_sink[j]) @ w_o_swa[j]
        xp = post_norm_residual(xp, yp, norm_g[i, 1], mp[2])
        xs = post_norm_residual(xs, ys, norm_g[i, 1], ms[2])
        hp = pre_norm_modulate(xp, norm_g[i, 2], mp[3], mp[4])
        hs = pre_norm_modulate(xs, norm_g[i, 2], ms[3], ms[4])
        xp = post_norm_residual(xp, swiglu(hp, w_gate[i], w_up[i], w_down[i]), norm_g[i, 3], mp[5])
        xs = post_norm_residual(xs, swiglu(hs, w_gate[i], w_up[i], w_down[i]), norm_g[i, 3], ms[5])

    new_diff_k = jnp.stack(diff_k_out, axis=1)
    new_diff_v = jnp.stack(diff_v_out, axis=1)
    new_swa_k = jnp.stack(swa_k_out, axis=1)
    new_swa_v = jnp.stack(swa_v_out, axis=1)
    return (xp, xs, new_diff_k, new_diff_v, new_swa_k, new_swa_v)
```

```cpp
#include <hip/hip_runtime.h>
#include <hip/hip_cooperative_groups.h>
#include <cstdint>
#include <cstdio>
namespace cg = cooperative_groups;

typedef unsigned short bf16_t;
typedef short bf16x8 __attribute__((ext_vector_type(8)));
typedef short s16x4 __attribute__((ext_vector_type(4)));
typedef float f32x4 __attribute__((ext_vector_type(4)));
typedef float f32x2 __attribute__((ext_vector_type(2)));
typedef unsigned u32x4 __attribute__((ext_vector_type(4)));
typedef unsigned u32x2 __attribute__((ext_vector_type(2)));
typedef __bf16 bf2_t __attribute__((ext_vector_type(2)));
#define DI __device__ __forceinline__
#define MFMA16(a, b, c) __builtin_amdgcn_mfma_f32_16x16x32_bf16((a), (b), (c), 0, 0, 0)

constexpr int D = 1024, NTOK = 8192, NPROMPT = 4096, DFF = 2816;
constexpr float EPS = 1e-6f, LOG2E = 1.4426950408889634f, SC = 0.125f * 1.4426950408889634f;

constexpr size_t OFF_MOD = 0;
constexpr size_t OFF_ROPE = 147456;
constexpr size_t OFF_BAR = 163840;
constexpr size_t OFF_WQKV0 = 1u << 20;
constexpr size_t OFF_WO0 = OFF_WQKV0 + 3072ull * 1024 * 2;
constexpr size_t OFF_WGU0 = OFF_WO0 + 1024ull * 1024 * 2;
constexpr size_t OFF_WD0 = OFF_WGU0 + 5632ull * 1024 * 2;
constexpr size_t OFF_WQKV1 = OFF_WD0 + 1024ull * 2816 * 2;
constexpr size_t OFF_WO1 = OFF_WQKV1 + 1536ull * 1024 * 2;
constexpr size_t OFF_WGU1 = OFF_WO1 + 1024ull * 1024 * 2;
constexpr size_t OFF_WD1 = OFF_WGU1 + 5632ull * 1024 * 2;
constexpr size_t OFF_CKD = OFF_WD1 + 1024ull * 2816 * 2;
constexpr size_t OFF_CVD = OFF_CKD + 1024ull * 1024 * 2;
constexpr size_t OFF_CKS = OFF_CVD + 1024ull * 1024 * 2;
constexpr size_t OFF_CVS = OFF_CKS + 1024ull * 256 * 2;
constexpr size_t OFF_H = OFF_CVS + 1024ull * 256 * 2;
constexpr size_t OFF_Q = OFF_H + 8192ull * 1024 * 2;
constexpr size_t OFF_K = OFF_Q + 8192ull * 1024 * 2;
constexpr size_t OFF_V = OFF_K + 8192ull * 1024 * 2;
constexpr size_t OFF_U = OFF_Q;
constexpr size_t OFF_O = OFF_V + 8192ull * 1024 * 2;
constexpr size_t OFF_Y = OFF_O + 8192ull * 1024 * 2;
constexpr size_t OFF_X = OFF_Y + 8192ull * 1024 * 4;
constexpr size_t WS_END = OFF_X + 8192ull * 1024 * 4;
static_assert(8192ull * 2816 * 2 <= 3 * 8192ull * 1024 * 2, "U overlay");

constexpr size_t OUT_Y = 0, OUT_NDK = 8388608, OUT_NDV = 12582912, OUT_NSK = 16777216, OUT_NSV = 17825792;

constexpr int NTHR = 512, NWAVE = 8;
constexpr int LDS_MAIN = 147456, LDS_BYTES = LDS_MAIN + 16;

struct Params {
    const float *x_prompt, *x_sample, *cdk, *cdv, *csk, *csv, *c, *c_ctx, *w_mod, *b_mod, *norm_g, *w_qkv_diff, *diff_lambda, *diff_subln_g,
        *w_o_diff, *w_qkv_swa, *swa_sink, *w_o_swa, *w_gate, *w_up, *w_down;
    float* out;
    char* ws;
};

DI unsigned pack2(float a, float b) { bf2_t v; v[0] = (__bf16)a; v[1] = (__bf16)b; return __builtin_bit_cast(unsigned, v); }
DI float wave_sum(float v) {
#pragma unroll
    for (int o = 32; o > 0; o >>= 1) v += __shfl_xor(v, o);
    return v;
}
DI float rows_max(float v) {
    auto a = __builtin_amdgcn_permlane16_swap(__float_as_uint(v), __float_as_uint(v), false, false);
    v = fmaxf(__uint_as_float(a[0]), __uint_as_float(a[1]));
    auto b = __builtin_amdgcn_permlane32_swap(__float_as_uint(v), __float_as_uint(v), false, false);
    return fmaxf(__uint_as_float(b[0]), __uint_as_float(b[1]));
}
DI float rows_sum(float v) {
    auto a = __builtin_amdgcn_permlane16_swap(__float_as_uint(v), __float_as_uint(v), false, false);
    v = __uint_as_float(a[0]) + __uint_as_float(a[1]);
    auto b = __builtin_amdgcn_permlane32_swap(__float_as_uint(v), __float_as_uint(v), false, false);
    return __uint_as_float(b[0]) + __uint_as_float(b[1]);
}
DI float silu_f(float x) { return x * __builtin_amdgcn_rcpf(1.f + __expf(-x)); }


#define XB_TMO      128
#define XB_XCNT(j)  (256  + 64 * (j))
#define XB_XSUB(j)  (1280 + 64 * (j))
#define XB_XGEN(j)  (2304 + 64 * (j))
#define XB_TOP      3328
#define XB_TOPGEN   3392
#define XCD_BAR_WORDS 3456
#define XB_SPIN_CAP (1u << 18)
#define LAS __attribute__((address_space(3)))
DI unsigned xb_ld(unsigned* p) { return __hip_atomic_load(p, __ATOMIC_RELAXED, __HIP_MEMORY_SCOPE_AGENT); }
DI unsigned xb_add(unsigned* p, unsigned v) { return __hip_atomic_fetch_add(p, v, __ATOMIC_RELAXED, __HIP_MEMORY_SCOPE_AGENT); }
DI unsigned xb_xcc_id() { return (unsigned)__builtin_amdgcn_s_getreg((3 << 11) | 20) & 0xFu; }
#define XB_SPIN(cond, bar) do { unsigned _sp = 0; while (cond) { __builtin_amdgcn_s_sleep(1); \
    if ((++_sp & 255u) == 0u) { if (xb_ld(&(bar)[XB_TMO])) break; if (_sp > XB_SPIN_CAP) { atomicAdd(&(bar)[XB_TMO], 1u); break; } } } } while (0)
struct XcdBarrier { unsigned* bar; unsigned x; volatile LAS unsigned* st; };
DI XcdBarrier xcd_barrier_post(unsigned* bar, volatile LAS unsigned* st) {
    XcdBarrier b; b.bar = bar; b.x = xb_xcc_id(); b.st = st;
    if (threadIdx.x == 0) (void)xb_add(&bar[XB_XCNT(b.x)], 1u);
    return b;
}
DI void xcd_barrier_complete(unsigned* bar, unsigned x, unsigned& nloc, unsigned& nx) {
    const unsigned G = gridDim.x * gridDim.y * gridDim.z;
    unsigned sum, cnt, mine, sp = 0u;
    for (;;) {
        sum = 0u; cnt = 0u; mine = 0u;
#pragma unroll
        for (unsigned j = 0; j < 16; ++j) { const unsigned c = xb_ld(&bar[XB_XCNT(j)]); sum += c; cnt += (c > 0u) ? 1u : 0u; mine = (j == x) ? c : mine; }
        if (sum == G) break;
        __builtin_amdgcn_s_sleep(1);
        if ((++sp & 255u) == 0u) { if (xb_ld(&bar[XB_TMO])) break; if (sp > XB_SPIN_CAP) { atomicAdd(&bar[XB_TMO], 1u); break; } }
    }
    nloc = mine > 0u ? mine : 1u; nx = cnt > 0u ? cnt : 1u;
}
DI void xcd_barrier(const XcdBarrier& b) {
    asm volatile("s_waitcnt vmcnt(0)" ::: "memory");
    __syncthreads();
    if (threadIdx.x == 0) {
        unsigned* bar = b.bar;
        __builtin_amdgcn_s_waitcnt(0);
        unsigned nloc = b.st[0], nx = b.st[1];
        if (nloc == 0u) { xcd_barrier_complete(bar, b.x, nloc, nx); b.st[0] = nloc; b.st[1] = nx; }
        const unsigned old = xb_add(&bar[XB_XSUB(b.x)], 1u);
        const unsigned gen = old / nloc;
        if (old + 1u == (gen + 1u) * nloc) {
            __builtin_amdgcn_fence(__ATOMIC_RELEASE, "agent");
            asm volatile("s_waitcnt vmcnt(0)" ::: "memory");
            const unsigned og = xb_add(&bar[XB_TOP], 1u);
            const unsigned tg = og / nx;
            if (og + 1u == (tg + 1u) * nx) xb_add(&bar[XB_TOPGEN], 1u);
            else XB_SPIN(xb_ld(&bar[XB_TOPGEN]) == tg, bar);
            __builtin_amdgcn_fence(__ATOMIC_ACQUIRE, "agent");
            xb_add(&bar[XB_XGEN(b.x)], 1u);
            asm volatile("s_waitcnt vmcnt(0)" ::: "memory");
        } else {
            XB_SPIN(xb_ld(&bar[XB_XGEN(b.x)]) == gen, bar);
            __builtin_amdgcn_fence(__ATOMIC_ACQUIRE, "agent");
            asm volatile("s_waitcnt vmcnt(0)" ::: "memory");
        }
    }
    __syncthreads();
}

DI void transpose_item_wave(const float* __restrict__ src, int ld, int k0, int c0, bf16_t* __restrict__ dst, int K, int nrow0, float* scr, int lane) {
#pragma unroll 8
    for (int i = 0; i < 32; ++i) { const int kk = 2 * i + (lane >> 5); scr[kk * 33 + (lane & 31)] = src[(size_t)(k0 + kk) * ld + c0 + (lane & 31)]; }
    asm volatile("s_waitcnt lgkmcnt(0)" ::: "memory");
    const int c = lane & 7;
#pragma unroll
    for (int j = 0; j < 4; ++j) {
        const int n = (lane >> 3) + 8 * j;
        const float* r = scr + (8 * c) * 33 + n;
        u32x4 o;
        o[0] = pack2(r[0 * 33], r[1 * 33]); o[1] = pack2(r[2 * 33], r[3 * 33]); o[2] = pack2(r[4 * 33], r[5 * 33]); o[3] = pack2(r[6 * 33], r[7 * 33]);
        *(u32x4*)(dst + (size_t)(nrow0 + n) * K + k0 + 8 * c) = o;
    }
    asm volatile("s_waitcnt lgkmcnt(0)" ::: "memory");
}

DI void tr_block_item(const Params& p, int bi, char* lds) {
    const int tid = threadIdx.x;
    int ti = bi * NWAVE + (tid >> 6);
    const int l = ti >= 6272 ? 1 : 0; ti -= l * 6272;
    const int nq = l ? 1536 : 3072, i_qkv = 16 * (nq / 32);
    const float* src; const float* src2 = nullptr; int ld, K; bf16_t* dst; bool gu = false;
    if (ti < i_qkv) { src = l ? p.w_qkv_swa : p.w_qkv_diff; ld = nq; K = 1024; dst = (bf16_t*)(p.ws + (l ? OFF_WQKV1 : OFF_WQKV0)); }
    else if ((ti -= i_qkv) < 512) { src = l ? p.w_o_swa : p.w_o_diff; ld = 1024; K = 1024; dst = (bf16_t*)(p.ws + (l ? OFF_WO1 : OFF_WO0)); }
    else if ((ti -= 512) < 2816) { src = p.w_gate + (size_t)l * 1024 * 2816; src2 = p.w_up + (size_t)l * 1024 * 2816; ld = 2816; K = 1024; dst = (bf16_t*)(p.ws + (l ? OFF_WGU1 : OFF_WGU0)); gu = true; }
    else { ti -= 2816; src = p.w_down + (size_t)l * 2816 * 1024; ld = 1024; K = 2816; dst = (bf16_t*)(p.ws + (l ? OFF_WD1 : OFF_WD0)); }
    const int nkb = K / 64, kb = ti % nkb, nb = ti / nkb;
    int c0 = nb * 32;
    if (gu) { const int tile = nb >> 2, wc = (nb >> 1) & 1, isup = nb & 1; c0 = tile * 64 + wc * 32; if (isup) src = src2; }
    transpose_item_wave(src, ld, kb * 64, c0, dst, K, nb * 32, (float*)lds + (tid >> 6) * (64 * 33), tid & 63);
}
constexpr int TR_P0 = 192, TR_ALL = 1472;
__device__ void deferred_transposes(const Params& p, char* lds) {
    __syncthreads();
    for (int bi = TR_P0 + blockIdx.x; bi < TR_ALL; bi += gridDim.x) tr_block_item(p, bi, lds);
    __syncthreads();
}

__device__ void prepass(const Params& p, char* lds) {
    const int tid = threadIdx.x;
    constexpr int N_MOD = 192, N_ROPE = 2, N_TR = TR_P0, N_CACHE = 640;
    constexpr int TOTAL = N_MOD + N_ROPE + N_TR + N_CACHE;
    for (int it = blockIdx.x; it < TOTAL; it += gridDim.x) {
        if (it < N_MOD) {
            const int l = it / 96, n0 = (it % 96) * 64;
            float* sc = (float*)lds;
            float* red = sc + 3 * 1024;
            for (int e = tid; e < 3 * 1024; e += NTHR) {
                const int c = e >> 10, k = e & 1023;
                const float v = (c == 0) ? p.c_ctx[k] : p.c[(c - 1) * 1024 + k];
                sc[e] = silu_f(v);
            }
            __syncthreads();
            const int c4 = tid & 15, kg = tid >> 4;
            const float* w = p.w_mod + (size_t)l * 1024 * 6144 + (size_t)(kg * 32) * 6144 + n0 + c4 * 4;
            f32x4 a0 = {0.f, 0.f, 0.f, 0.f}, a1 = a0, a2 = a0;
#pragma unroll 8
            for (int k = 0; k < 32; ++k) {
                const f32x4 wv = *(const f32x4*)(w + (size_t)k * 6144);
                a0 += wv * sc[kg * 32 + k]; a1 += wv * sc[1024 + kg * 32 + k]; a2 += wv * sc[2048 + kg * 32 + k];
            }
            *(f32x4*)(red + (kg * 3 + 0) * 64 + c4 * 4) = a0; *(f32x4*)(red + (kg * 3 + 1) * 64 + c4 * 4) = a1; *(f32x4*)(red + (kg * 3 + 2) * 64 + c4 * 4) = a2;
            __syncthreads();
            if (tid < 192) {
                const int c = tid >> 6, cc = tid & 63;
                float s = p.b_mod[l * 6144 + n0 + cc];
#pragma unroll
                for (int q = 0; q < 32; ++q) s += red[(q * 3 + c) * 64 + cc];
                ((float*)(p.ws + OFF_MOD))[(l * 3 + c) * 6144 + n0 + cc] = s;
            }
            __syncthreads();
        } else if (it < N_MOD + N_ROPE) {
            float* rt = (float*)(p.ws + OFF_ROPE);
            const int e = (it - N_MOD) * NTHR + tid;
            const int pos = e >> 4, i = e & 15;
            const float inv = (float)exp2(-((double)i / 16.0) * 13.287712379549449);
            const float ang = (float)pos * inv;
            rt[e * 2] = (float)cos((double)ang);
            rt[e * 2 + 1] = (float)sin((double)ang);
        } else if (it < N_MOD + N_ROPE + N_TR) {
            tr_block_item(p, it - (N_MOD + N_ROPE), lds);
        } else {
            int ci = it - (N_MOD + N_ROPE + N_TR);
            const float* src; bf16_t* dst;
            if (ci < 256) { src = p.cdk; dst = (bf16_t*)(p.ws + OFF_CKD); }
            else if (ci < 512) { src = p.cdv; dst = (bf16_t*)(p.ws + OFF_CVD); ci -= 256; }
            else if (ci < 576) { src = p.csk; dst = (bf16_t*)(p.ws + OFF_CKS); ci -= 512; }
            else { src = p.csv; dst = (bf16_t*)(p.ws + OFF_CVS); ci -= 576; }
            const size_t e = (size_t)ci * 4096 + tid * 8;
            const f32x4 a = *(const f32x4*)(src + e), b = *(const f32x4*)(src + e + 4);
            u32x4 o; o[0] = pack2(a[0], a[1]); o[1] = pack2(a[2], a[3]); o[2] = pack2(b[0], b[1]); o[3] = pack2(b[2], b[3]);
            *(u32x4*)(dst + e) = o;
        }
    }
}

DI void bf8_to_f32(const u32x4 r, f32x4& a, f32x4& b) {
    a = (f32x4){__uint_as_float(r[0] << 16), __uint_as_float(r[0] & 0xffff0000u), __uint_as_float(r[1] << 16), __uint_as_float(r[1] & 0xffff0000u)};
    b = (f32x4){__uint_as_float(r[2] << 16), __uint_as_float(r[2] & 0xffff0000u), __uint_as_float(r[3] << 16), __uint_as_float(r[3] & 0xffff0000u)};
}
DI u32x4 f32_to_bf8(const f32x4 a, const f32x4 b) { u32x4 o; o[0] = pack2(a[0], a[1]); o[1] = pack2(a[2], a[3]); o[2] = pack2(b[0], b[1]); o[3] = pack2(b[2], b[3]); return o; }

template <int MODE>
__device__ void rowphase(const Params& p, int layer) {
    const int lane = threadIdx.x & 63, w = threadIdx.x >> 6;
    const float* mod = (const float*)(p.ws + OFF_MOD);
    bf16_t* xbuf = (bf16_t*)(p.ws + OFF_X);
    const bf16_t* ybuf = (const bf16_t*)(p.ws + OFF_Y);
    bf16_t* hbuf = (bf16_t*)(p.ws + OFF_H);
    constexpr int RB = 4;
    const bool last = (MODE == 2 && layer == 1);
    for (int rb = blockIdx.x * NWAVE + w; rb < NTOK / RB; rb += gridDim.x * NWAVE) {
        const int rowb = rb * RB;
        const int cond = rowb < NPROMPT ? 0 : 1 + ((rowb - NPROMPT) >> 11);
        const float* mrow = mod + (size_t)(layer * 3 + cond) * 6144;
        const int nl = (MODE == 2) ? layer + 1 : layer;
        const float* mrow2 = mod + (size_t)(nl * 3 + cond) * 6144;
        f32x4 vgpost[4], vgate[4], vgpre[4], vshift[4], vscale[4];
#pragma unroll
        for (int q = 0; q < 4; ++q) {
            const int o = (q >> 1) * 512 + lane * 8 + (q & 1) * 4;
            if (MODE != 0) {
                vgpost[q] = *(const f32x4*)(p.norm_g + (size_t)(layer * 4 + (MODE == 1 ? 1 : 3)) * D + o);
                vgate[q] = *(const f32x4*)(mrow + (MODE == 1 ? 2 : 5) * D + o);
            }
            if (!last) {
                vgpre[q] = *(const f32x4*)(p.norm_g + (size_t)(nl * 4 + (MODE == 1 ? 2 : 0)) * D + o);
                vshift[q] = *(const f32x4*)(mrow2 + (MODE == 1 ? 3 : 0) * D + o);
                vscale[q] = *(const f32x4*)(mrow2 + (MODE == 1 ? 4 : 1) * D + o) + 1.f;
            }
        }
#pragma unroll 4
        for (int j = 0; j < RB; ++j) {
            const int row = rowb + j;
            f32x4 x[4];
            if (MODE == 2 || layer == 1) {
#pragma unroll
                for (int i = 0; i < 2; ++i) bf8_to_f32(*(const u32x4*)(xbuf + (size_t)row * D + i * 512 + lane * 8), x[2 * i], x[2 * i + 1]);
            } else {
                const float* xin = row < NPROMPT ? p.x_prompt + (size_t)row * D : p.x_sample + (size_t)(row - NPROMPT) * D;
#pragma unroll
                for (int q = 0; q < 4; ++q) x[q] = *(const f32x4*)(xin + (q >> 1) * 512 + lane * 8 + (q & 1) * 4);
            }
            if (MODE != 0) {
                f32x4 y[4];
                float ss = 0.f;
#pragma unroll
                for (int i = 0; i < 2; ++i) bf8_to_f32(*(const u32x4*)(ybuf + (size_t)row * D + i * 512 + lane * 8), y[2 * i], y[2 * i + 1]);
#pragma unroll
                for (int q = 0; q < 4; ++q) ss += y[q][0] * y[q][0] + y[q][1] * y[q][1] + y[q][2] * y[q][2] + y[q][3] * y[q][3];
                ss = wave_sum(ss);
                const float rstd = rsqrtf(ss * (1.f / D) + EPS);
#pragma unroll
                for (int q = 0; q < 4; ++q) x[q] = x[q] + vgate[q] * (y[q] * rstd * vgpost[q]);
#pragma unroll
                for (int i = 0; i < 2; ++i) {
                    if (last) {
                        *(f32x4*)(p.out + OUT_Y + (size_t)row * D + i * 512 + lane * 8) = x[2 * i];
                        *(f32x4*)(p.out + OUT_Y + (size_t)row * D + i * 512 + lane * 8 + 4) = x[2 * i + 1];
                    } else *(u32x4*)(xbuf + (size_t)row * D + i * 512 + lane * 8) = f32_to_bf8(x[2 * i], x[2 * i + 1]);
                }
            }
            if (last) continue;
            float ss = 0.f;
#pragma unroll
            for (int q = 0; q < 4; ++q) ss += x[q][0] * x[q][0] + x[q][1] * x[q][1] + x[q][2] * x[q][2] + x[q][3] * x[q][3];
            ss = wave_sum(ss);
            const float rstd = rsqrtf(ss * (1.f / D) + EPS);
#pragma unroll
            for (int i = 0; i < 2; ++i) {
                const f32x4 h0 = (x[2 * i] * rstd * vgpre[2 * i]) * vscale[2 * i] + vshift[2 * i];
                const f32x4 h1 = (x[2 * i + 1] * rstd * vgpre[2 * i + 1]) * vscale[2 * i + 1] + vshift[2 * i + 1];
                *(u32x4*)(hbuf + (size_t)row * D + i * 512 + lane * 8) = f32_to_bf8(h0, h1);
            }
        }
    }
}

DI void store_pair16(bf16_t* rowp, u32x2 A, u32x2 B, int g) {
    auto r0 = __builtin_amdgcn_permlane16_swap(A[0], B[0], false, false);
    auto r1 = __builtin_amdgcn_permlane16_swap(A[1], B[1], false, false);
    u32x4 o; o[0] = r0[0]; o[1] = r1[0]; o[2] = r0[1]; o[3] = r1[1];
    *(u32x4*)(rowp + ((g & 1) ? 16 + (g - 1) * 4 : g * 4)) = o;
}
enum { EPI_F32 = 0, EPI_QKV_DIFF = 1, EPI_QKV_SWA = 2, EPI_GU = 3 };

template <int EPI>
__device__ void gemm_phase(const Params& p, const bf16_t* __restrict__ A, const bf16_t* __restrict__ Bt, const int N, const int K, char* lds) {
    const int tid = threadIdx.x, lane = tid & 63, w = __builtin_amdgcn_readfirstlane(tid >> 6), wr = w >> 1, wc = w & 1, lr = lane & 15, g = lane >> 4;
    const int nN = N >> 7, ntiles = 32 * nN, nk = K >> 6;
    const int rin = lane >> 3, chp = lane & 7;
    const unsigned loffE = (unsigned)(rin * K + ((chp ^ (rin >> 1)) << 3)) * 2u;
    const unsigned loffO = (unsigned)(rin * K + ((chp ^ (rin >> 1) ^ 4) << 3)) * 2u;
    const int fsw = lr >> 1;
    const int half = w >> 2;
#define GEMM_STAGE(ga_, gb_, kt_, buf_) do { \
        char* _d = lds + (buf_) * 49152; \
        const size_t _k = (size_t)(kt_) * 64; \
        unsigned _lE = loffE, _lO = loffO; asm volatile("" : "+v"(_lE), "+v"(_lO)); \
        _Pragma("unroll") for (int _i = 0; _i < 4; ++_i) { \
            const char* _b = (const char*)((ga_) + (size_t)(w * 32 + _i * 8) * K + _k); \
            __builtin_amdgcn_global_load_lds((const unsigned*)(_b + ((_i & 1) ? _lO : _lE)), (__attribute__((address_space(3))) unsigned*)(_d + w * 4096 + _i * 1024), 16, 0, 0); } \
        _Pragma("unroll") for (int _i = 0; _i < 2; ++_i) { \
            const char* _b = (const char*)((gb_) + (size_t)(w * 16 + _i * 8) * K + _k); \
            __builtin_amdgcn_global_load_lds((const unsigned*)(_b + ((_i & 1) ? _lO : _lE)), (__attribute__((address_space(3))) unsigned*)(_d + 32768 + w * 2048 + _i * 1024), 16, 0, 0); } \
    } while (0)
#define GEMM_PIECE(ga_, gb_, kt_, buf_, pc_) do { \
        char* _d = lds + (buf_) * 49152; \
        const size_t _k = (size_t)(kt_) * 64; \
        unsigned _l = ((pc_) & 1) ? loffO : loffE; asm volatile("" : "+v"(_l)); \
        if ((pc_) < 4) { const char* _b = (const char*)((ga_) + (size_t)(w * 32 + (pc_) * 8) * K + _k); \
            __builtin_amdgcn_global_load_lds((const unsigned*)(_b + _l), (__attribute__((address_space(3))) unsigned*)(_d + w * 4096 + (pc_) * 1024), 16, 0, 0); } \
        else { const char* _b = (const char*)((gb_) + (size_t)(w * 16 + ((pc_) - 4) * 8) * K + _k); \
            __builtin_amdgcn_global_load_lds((const unsigned*)(_b + _l), (__attribute__((address_space(3))) unsigned*)(_d + 32768 + w * 2048 + ((pc_) - 4) * 1024), 16, 0, 0); } \
    } while (0)
    int t = blockIdx.x;
    if (t >= ntiles) return;
    int cur = 0;
    {
        const bf16_t* ga = A + (size_t)((t & 31) * 256) * K;
        const bf16_t* gb = Bt + (size_t)((t >> 5) * 128) * K;
        __syncthreads();
        GEMM_STAGE(ga, gb, 0, 0);
        GEMM_STAGE(ga, gb, 1, 1);
    }
    bool first = true;
    for (; t < ntiles; t += gridDim.x) {
        const int pm = t & 31, pn = t >> 5;
        const int m0 = pm * 256, n0 = pn * 128;
        f32x4 acc[4][4];
#pragma unroll
        for (int i = 0; i < 4; ++i)
#pragma unroll
            for (int j = 0; j < 4; ++j) acc[i][j] = (f32x4){0.f, 0.f, 0.f, 0.f};
        const bf16_t* ga = A + (size_t)m0 * K;
        const bf16_t* gb = Bt + (size_t)n0 * K;
        const int tn = t + gridDim.x;
        const bool has_next = tn < ntiles;
        const bf16_t* ga2 = A + (size_t)((tn & 31) * 256) * K;
        const bf16_t* gb2 = Bt + (size_t)((tn >> 5) * 128) * K;
        bf16x8 af[2][4], bfr[2][4];
#define GEMM_READ() do { \
            _Pragma("unroll") for (int ks = 0; ks < 2; ++ks) { \
                const int coff = ((ks * 4 + g) ^ fsw) << 4; \
                _Pragma("unroll") for (int mt = 0; mt < 4; ++mt) af[ks][mt] = *(const bf16x8*)(sa + (wr * 64 + mt * 16 + lr) * 128 + coff); \
                _Pragma("unroll") for (int nt = 0; nt < 4; ++nt) bfr[ks][nt] = *(const bf16x8*)(sb + (wc * 64 + nt * 16 + lr) * 128 + coff); \
            } } while (0)
#define GEMM_MMA() do { \
            _Pragma("unroll") for (int ks = 0; ks < 2; ++ks) \
                _Pragma("unroll") for (int mt = 0; mt < 4; ++mt) \
                    _Pragma("unroll") for (int nt = 0; nt < 4; ++nt) acc[mt][nt] = MFMA16(bfr[ks][nt], af[ks][mt], acc[mt][nt]); \
            } while (0)
#define GEMM_MMA_DMA(kt_) do { \
            const int slot2 = (cur == 0) ? 2 : cur - 1; \
            const bool _own = (kt_) + 2 < nk; const bool _any = _own || has_next; \
            const bf16_t* _ga = _own ? ga : ga2; const bf16_t* _gb = _own ? gb : gb2; const int _kk = _own ? (kt_) + 2 : (kt_) + 2 - nk; \
            _Pragma("unroll") for (int ks = 0; ks < 2; ++ks) \
                _Pragma("unroll") for (int mt = 0; mt < 4; ++mt) { \
                    _Pragma("unroll") for (int nt = 0; nt < 4; ++nt) acc[mt][nt] = MFMA16(bfr[ks][nt], af[ks][mt], acc[mt][nt]); \
                    const int _g = ks * 4 + mt; \
                    if ((_g == 1 || _g == 3 || _g == 5) && _any) { __builtin_amdgcn_sched_barrier(0); GEMM_PIECE(_ga, _gb, _kk, slot2, (_g - 1) >> 1); __builtin_amdgcn_sched_barrier(0); } \
                } \
            } while (0)
#define GEMM_SLOT_A(kt_) do { \
            if ((kt_) == 0) { if (first) asm volatile("s_waitcnt vmcnt(6) lgkmcnt(0)" ::: "memory"); else asm volatile("s_waitcnt lgkmcnt(0)" ::: "memory"); } \
            else if ((kt_) + 1 < nk || has_next) asm volatile("s_waitcnt vmcnt(6) lgkmcnt(0)" ::: "memory"); \
            else asm volatile("s_waitcnt vmcnt(0) lgkmcnt(0)" ::: "memory"); \
            __builtin_amdgcn_sched_barrier(0); __builtin_amdgcn_s_barrier(); __builtin_amdgcn_sched_barrier(0); \
            asm volatile("" ::: "memory"); \
        } while (0)
#define GEMM_MID_BAR() do { \
            asm volatile("s_waitcnt lgkmcnt(0)" ::: "memory"); \
            __builtin_amdgcn_sched_barrier(0); __builtin_amdgcn_s_barrier(); __builtin_amdgcn_sched_barrier(0); \
            asm volatile("" ::: "memory"); \
        } while (0)
#define GEMM_REST(kt_) do { \
            asm volatile("s_waitcnt lgkmcnt(0)" ::: "memory"); \
            __builtin_amdgcn_sched_barrier(0); \
            const int slot2 = (cur == 0) ? 2 : cur - 1; \
            const bool _own = (kt_) + 2 < nk; \
            if (_own || has_next) { \
                const bf16_t* _ga = _own ? ga : ga2; const bf16_t* _gb = _own ? gb : gb2; const int _kk = _own ? (kt_) + 2 : (kt_) + 2 - nk; \
                GEMM_PIECE(_ga, _gb, _kk, slot2, 3); GEMM_PIECE(_ga, _gb, _kk, slot2, 4); GEMM_PIECE(_ga, _gb, _kk, slot2, 5); } \
            __builtin_amdgcn_sched_barrier(0); \
        } while (0)
        if (half == 0) {
            for (int kt = 0; kt < nk; ++kt) {
                GEMM_SLOT_A(kt);
                const char* sa = lds + cur * 49152;
                const char* sb = sa + 32768;
                GEMM_READ();
                GEMM_REST(kt);
                GEMM_MID_BAR();
                GEMM_MMA_DMA(kt);
                cur = (cur == 2) ? 0 : cur + 1;
            }
        } else {
            for (int kt = 0; kt < nk; ++kt) {
                GEMM_SLOT_A(kt);
                if (kt > 0) GEMM_MMA_DMA(kt);
                else { const int slot2 = (cur == 0) ? 2 : cur - 1; GEMM_PIECE(ga, gb, 2, slot2, 0); GEMM_PIECE(ga, gb, 2, slot2, 1); GEMM_PIECE(ga, gb, 2, slot2, 2); }
                GEMM_MID_BAR();
                const char* sa = lds + cur * 49152;
                const char* sb = sa + 32768;
                GEMM_READ();
                GEMM_REST(kt);
                cur = (cur == 2) ? 0 : cur + 1;
            }
            asm volatile("s_waitcnt lgkmcnt(0)" ::: "memory");
            GEMM_MMA();
        }
#undef GEMM_REST
#undef GEMM_SLOT_A
#undef GEMM_MID_BAR
        if (has_next) asm volatile("s_waitcnt vmcnt(6)" ::: "memory");
        first = false;
#undef GEMM_READ
#undef GEMM_MMA
#undef GEMM_MMA_DMA
        const int mbase = m0 + wr * 64 + lr;
        const int nbase = n0 + wc * 64 + g * 4;
        if (EPI == EPI_F32) {
            bf16_t* Y = (bf16_t*)(p.ws + OFF_Y);
#pragma unroll
            for (int mt = 0; mt < 4; ++mt)
#pragma unroll
                for (int np = 0; np < 2; ++np) {
                    const f32x4 v0 = acc[mt][2 * np], v1 = acc[mt][2 * np + 1];
                    u32x2 a, b; a[0] = pack2(v0[0], v0[1]); a[1] = pack2(v0[2], v0[3]); b[0] = pack2(v1[0], v1[1]); b[1] = pack2(v1[2], v1[3]);
                    store_pair16(Y + (size_t)(mbase + mt * 16) * N + n0 + wc * 64 + np * 32, a, b, g);
                }
        } else if (EPI == EPI_GU) {
            bf16_t* U = (bf16_t*)(p.ws + OFF_U);
#pragma unroll
            for (int mt = 0; mt < 4; ++mt) {
                u32x2 o[2];
#pragma unroll
                for (int nt = 0; nt < 2; ++nt) {
                    const f32x4 gt = acc[mt][nt], up = acc[mt][nt + 2];
                    o[nt][0] = pack2(silu_f(gt[0]) * up[0], silu_f(gt[1]) * up[1]);
                    o[nt][1] = pack2(silu_f(gt[2]) * up[2], silu_f(gt[3]) * up[3]);
                }
                store_pair16(U + (size_t)(mbase + mt * 16) * DFF + pn * 64 + wc * 32, o[0], o[1], g);
            }
        } else {
            const int ncol0 = n0 + wc * 64;
            int sec, cofs, pitch;
            if (EPI == EPI_QKV_DIFF) { sec = ncol0 >> 10; cofs = ncol0 & 1023; pitch = 1024; }
            else { sec = ncol0 < 1024 ? 0 : (ncol0 < 1280 ? 1 : 2); cofs = sec == 0 ? ncol0 : (sec == 1 ? ncol0 - 1024 : ncol0 - 1280); pitch = sec == 0 ? 1024 : 256; }
            const bool latent = m0 >= NPROMPT;
            if (latent && sec < 2) {
                const float* rt = (const float*)(p.ws + OFF_ROPE);
#pragma unroll
                for (int mt = 0; mt < 4; ++mt) {
                    const int tl = (mbase + mt * 16 - NPROMPT) & 2047;
                    const int prow = tl >> 6, pcol = tl & 63;
                    const f32x4 r0 = *(const f32x4*)(rt + (prow * 16 + g * 4) * 2), r1 = *(const f32x4*)(rt + (prow * 16 + g * 4) * 2 + 4);
                    const f32x4 c0 = *(const f32x4*)(rt + (pcol * 16 + g * 4) * 2), c1 = *(const f32x4*)(rt + (pcol * 16 + g * 4) * 2 + 4);
                    const float cr[4] = {r0[0], r0[2], r1[0], r1[2]}, sr[4] = {r0[1], r0[3], r1[1], r1[3]};
                    const float cc[4] = {c0[0], c0[2], c1[0], c1[2]}, sc[4] = {c0[1], c0[3], c1[1], c1[3]};
#pragma unroll
                    for (int r = 0; r < 4; ++r) {
                        const float x1 = acc[mt][0][r], x2 = acc[mt][1][r], x3 = acc[mt][2][r], x4 = acc[mt][3][r];
                        acc[mt][0][r] = x1 * cr[r] - x2 * sr[r];
                        acc[mt][1][r] = x2 * cr[r] + x1 * sr[r];
                        acc[mt][2][r] = x3 * cc[r] - x4 * sc[r];
                        acc[mt][3][r] = x4 * cc[r] + x3 * sc[r];
                    }
                }
            }
            bf16_t* dstb = (bf16_t*)(p.ws + (sec == 0 ? OFF_Q : (sec == 1 ? OFF_K : OFF_V)));
            float* dstf = nullptr;
            if (!latent && sec > 0) {
                if (EPI == EPI_QKV_DIFF) dstf = p.out + (sec == 1 ? OUT_NDK : OUT_NDV);
                else dstf = p.out + (sec == 1 ? OUT_NSK : OUT_NSV);
            }
#pragma unroll
            for (int mt = 0; mt < 4; ++mt) {
                u32x2 o[4];
#pragma unroll
                for (int nt = 0; nt < 4; ++nt) {
                    const size_t idx = (size_t)(mbase + mt * 16) * pitch + cofs + g * 4 + nt * 16;
                    const f32x4 v = acc[mt][nt];
                    const f32x4 vs = (sec == 0) ? v * SC : v;
                    o[nt][0] = pack2(vs[0], vs[1]); o[nt][1] = pack2(vs[2], vs[3]);
                    if (dstf) *(f32x4*)(dstf + idx) = v;
                }
                bf16_t* rowp = dstb + (size_t)(mbase + mt * 16) * pitch + cofs;
                store_pair16(rowp, o[0], o[1], g);
                store_pair16(rowp + 32, o[2], o[3], g);
            }
        }
    }
}

#undef GEMM_STAGE
template <bool DIFF>
__device__ void attn_phase(const Params& p, char* lds) {
    constexpr int DV = DIFF ? 128 : 64, MT = DV / 16;
    constexpr int KBYTES = DIFF ? 16384 : 8192, VPITCH = DV * 2 + 32, BUFB = KBYTES + 64 * VPITCH;
    constexpr int NCH = DIFF ? 2 : 1, KSTEP = DIFF ? 32 : 64, PITCH = DIFF ? 1024 : 256;
    static_assert(2 * BUFB <= LDS_MAIN, "lds");
    const int tid = threadIdx.x, lane = tid & 63, w = tid >> 6, sub = w & 1, qg = w >> 1, lr = lane & 15, g = lane >> 4;
    const bf16_t* qbuf = (const bf16_t*)(p.ws + OFF_Q);
    const bf16_t* kbuf = (const bf16_t*)(p.ws + OFF_K);
    const bf16_t* vbuf = (const bf16_t*)(p.ws + OFF_V);
    bf16_t* obuf = (bf16_t*)(p.ws + OFF_O);
    float lam = 0.f;
    if (DIFF) {
        const float* dl = p.diff_lambda;
        const float a = wave_sum(dl[lane] * dl[64 + lane]), b = wave_sum(dl[128 + lane] * dl[192 + lane]);
        lam = __expf(a) - __expf(b) + 0.2f;
    }
    const int skey = DIFF ? (tid >> 4) : (tid >> 3), sch = DIFF ? (tid & 15) : (tid & 7);
    const int k_st = DIFF ? ((sch >> 3) * 8192 + skey * 128 + (((sch & 7) ^ ((skey >> 1) & 7)) << 4)) : (skey * 128 + ((sch ^ ((skey >> 1) & 7)) << 4));
    const int v_st = KBYTES + skey * VPITCH + sch * 16;
    const int g_off = skey * PITCH + sch * 8;

    const bool bg_first = (__popc(blockIdx.x) & 1) != 0;
    if (DIFF && bg_first) deferred_transposes(p, lds);
    for (int u = blockIdx.x; u < 512; u += gridDim.x) {
        int qtok0, n0t, t_lo, t_hi, vhead, qpos0 = 0;
        bool band = false;
        const bf16_t *K0 = nullptr, *V0 = nullptr, *K1, *V1;
        float m_init = 0.f, l_init = 0.f;
        if (DIFF) {
            int b, h, qb;
            if (u < 256) {
                const int xcd = u & 7, slot = u >> 3, bh = xcd * 2 + (slot >> 4);
                qb = slot & 15; b = bh >> 3; h = bh & 7;
                qtok0 = NPROMPT + b * 2048 + qb * 128;
                K0 = (const bf16_t*)(p.ws + OFF_CKD) + (size_t)(b * 512) * 1024 + h * 128;
                V0 = (const bf16_t*)(p.ws + OFF_CVD) + (size_t)(b * 512) * 1024 + h * 128;
                n0t = 8;
                K1 = kbuf + (size_t)(NPROMPT + b * 2048) * 1024 + h * 128;
                V1 = vbuf + (size_t)(NPROMPT + b * 2048) * 1024 + h * 128;
                t_lo = 0; t_hi = 32;
            } else {
                const int v = u - 256;
                b = v >> 4; h = (v >> 1) & 7; qb = v & 1;
                qtok0 = b * 256 + qb * 128;
                n0t = 0;
                K1 = kbuf + (size_t)(b * 256) * 1024 + h * 128;
                V1 = vbuf + (size_t)(b * 256) * 1024 + h * 128;
                t_lo = 0; t_hi = 4;
            }
            vhead = h * 2 + sub;
        } else {
            int b, kv, hp, qb;
            if (u < 256) {
                const int xcd = u & 7, slot = u >> 3;
                b = xcd >> 2; kv = xcd & 3; hp = slot >> 4; qb = slot & 15;
                qtok0 = NPROMPT + b * 2048 + qb * 128;
                K0 = (const bf16_t*)(p.ws + OFF_CKS) + (size_t)(b * 512) * 256 + kv * 64;
                V0 = (const bf16_t*)(p.ws + OFF_CVS) + (size_t)(b * 512) * 256 + kv * 64;
                n0t = 8;
                K1 = kbuf + (size_t)(NPROMPT + b * 2048) * 256 + kv * 64;
                V1 = vbuf + (size_t)(NPROMPT + b * 2048) * 256 + kv * 64;
                t_lo = 2 * qb - 2 < 0 ? 0 : 2 * qb - 2; t_hi = 2 * qb + 4 > 32 ? 32 : 2 * qb + 4;
                band = true; qpos0 = qb * 128;
            } else {
                const int v = u - 256;
                b = v >> 4; kv = (v >> 2) & 3; hp = (v >> 1) & 1; qb = v & 1;
                qtok0 = b * 256 + qb * 128;
                n0t = 0;
                K1 = kbuf + (size_t)(b * 256) * 256 + kv * 64;
                V1 = vbuf + (size_t)(b * 256) * 256 + kv * 64;
                t_lo = 0; t_hi = 4;
            }
            vhead = kv * 4 + hp * 2 + sub;
            m_init = p.swa_sink[vhead] * LOG2E;
            l_init = (g == 0) ? 1.f : 0.f;
        }
        const int ntile = n0t + (t_hi - t_lo);
        bf16x8 qf[2][2];
#pragma unroll
        for (int nt = 0; nt < 2; ++nt)
#pragma unroll
            for (int ks = 0; ks < 2; ++ks)
                qf[nt][ks] = *(const bf16x8*)(qbuf + (size_t)(qtok0 + qg * 32 + nt * 16 + lr) * 1024 + vhead * 64 + ks * 32 + g * 8);
        f32x4 O[MT][2];
#pragma unroll
        for (int i = 0; i < MT; ++i) { O[i][0] = (f32x4){0.f, 0.f, 0.f, 0.f}; O[i][1] = (f32x4){0.f, 0.f, 0.f, 0.f}; }
        float mrun[2] = {m_init, m_init}, lrun[2] = {l_init, l_init};

        u32x4 rk[NCH], rv[NCH];
        {
            const bf16_t* kp = (n0t > 0) ? K0 : K1 + (size_t)t_lo * 64 * PITCH;
            const bf16_t* vp = (n0t > 0) ? V0 : V1 + (size_t)t_lo * 64 * PITCH;
#pragma unroll
            for (int c = 0; c < NCH; ++c) { rk[c] = *(const u32x4*)(kp + g_off + c * KSTEP * PITCH); rv[c] = *(const u32x4*)(vp + g_off + c * KSTEP * PITCH); }
#pragma unroll
            for (int c = 0; c < NCH; ++c) { *(u32x4*)(lds + k_st + c * KSTEP * 128) = rk[c]; *(u32x4*)(lds + v_st + c * KSTEP * VPITCH) = rv[c]; }
        }
        __syncthreads();
        for (int i = 0; i < ntile; ++i) {
            const bool more = i + 1 < ntile;
            if (more) {
                const int j = i + 1;
                const bf16_t* kp = (j < n0t) ? K0 + (size_t)j * 64 * PITCH : K1 + (size_t)(t_lo + j - n0t) * 64 * PITCH;
                const bf16_t* vp = (j < n0t) ? V0 + (size_t)j * 64 * PITCH : V1 + (size_t)(t_lo + j - n0t) * 64 * PITCH;
#pragma unroll
                for (int c = 0; c < NCH; ++c) { rk[c] = *(const u32x4*)(kp + g_off + c * KSTEP * PITCH); rv[c] = *(const u32x4*)(vp + g_off + c * KSTEP * PITCH); }
            }
            __builtin_amdgcn_sched_barrier(0);
            const char* buf = lds + (i & 1) * BUFB;
            const char* kb = buf + (DIFF ? sub * 8192 : 0);
            const char* vb = buf + KBYTES;
            f32x4 S[4][2];
            const f32x4 cin0 = {-mrun[0], -mrun[0], -mrun[0], -mrun[0]}, cin1 = {-mrun[1], -mrun[1], -mrun[1], -mrun[1]};
#pragma unroll
            for (int kt = 0; kt < 4; ++kt) {
                const bf16x8 kf = *(const bf16x8*)(kb + (kt * 16 + lr) * 128 + ((g ^ (lr >> 1)) << 4));
                S[kt][0] = MFMA16(kf, qf[0][0], cin0);
                S[kt][1] = MFMA16(kf, qf[1][0], cin1);
            }
#pragma unroll
            for (int kt = 0; kt < 4; ++kt) {
                const bf16x8 kf = *(const bf16x8*)(kb + (kt * 16 + lr) * 128 + (((4 + g) ^ (lr >> 1)) << 4));
                S[kt][0] = MFMA16(kf, qf[0][1], S[kt][0]);
                S[kt][1] = MFMA16(kf, qf[1][1], S[kt][1]);
            }
            const bool domask = band && i >= n0t;
            const int kpos0 = (t_lo + i - n0t) * 64 + g * 4;
#pragma unroll
            for (int nt = 0; nt < 2; ++nt) {
                const int qpos = qpos0 + qg * 32 + nt * 16 + lr;
                float mx = -3.0e38f;
                if (domask) {
#pragma unroll
                    for (int kt = 0; kt < 4; ++kt)
#pragma unroll
                        for (int r = 0; r < 4; ++r) { const int dlt = qpos - (kpos0 + kt * 16 + r); if (dlt > 128 || dlt < -128) S[kt][nt][r] = -1e30f; }
                }
#pragma unroll
                for (int kt = 0; kt < 4; ++kt)
#pragma unroll
                    for (int r = 0; r < 4; ++r) mx = fmaxf(mx, S[kt][nt][r]);
                mx = rows_max(mx);
                const bool raise = (mx > 8.f) || (DIFF && i == 0);
                if (__builtin_amdgcn_ballot_w64(raise) != 0ull) {
                    const float delta = raise ? fmaxf(mx, -100.f) : 0.f;
                    const float alpha = __builtin_amdgcn_exp2f(-delta);
                    mrun[nt] += delta;
                    lrun[nt] *= alpha;
#pragma unroll
                    for (int mt = 0; mt < MT; ++mt) O[mt][nt] = O[mt][nt] * alpha;
#pragma unroll
                    for (int kt = 0; kt < 4; ++kt) S[kt][nt] = S[kt][nt] - delta;
                }
                float ls = 0.f;
#pragma unroll
                for (int kt = 0; kt < 4; ++kt)
#pragma unroll
                    for (int r = 0; r < 4; ++r) {
                        const float pv = __builtin_amdgcn_exp2f(S[kt][nt][r]);
                        S[kt][nt][r] = pv;
                        ls += pv;
                    }
                lrun[nt] += ls;
            }
#pragma unroll
            for (int ks2 = 0; ks2 < 2; ++ks2) {
                bf16x8 pf[2];
#pragma unroll
                for (int nt = 0; nt < 2; ++nt) {
                    u32x4 pk;
                    pk[0] = pack2(S[2 * ks2][nt][0], S[2 * ks2][nt][1]); pk[1] = pack2(S[2 * ks2][nt][2], S[2 * ks2][nt][3]);
                    pk[2] = pack2(S[2 * ks2 + 1][nt][0], S[2 * ks2 + 1][nt][1]); pk[3] = pack2(S[2 * ks2 + 1][nt][2], S[2 * ks2 + 1][nt][3]);
                    pf[nt] = __builtin_bit_cast(bf16x8, pk);
                }
                const char* vrow = vb + (ks2 * 32 + g * 4 + (lr >> 2)) * VPITCH + (lr & 3) * 8;
#pragma unroll
                for (int mt = 0; mt < MT; ++mt) {
                    const s16x4 v0 = __builtin_amdgcn_ds_read_tr16_b64_v4i16((s16x4 __attribute__((address_space(3)))*)(vrow + mt * 32));
                    const s16x4 v1 = __builtin_amdgcn_ds_read_tr16_b64_v4i16((s16x4 __attribute__((address_space(3)))*)(vrow + mt * 32 + 16 * VPITCH));
                    const bf16x8 vf = __builtin_shufflevector(v0, v1, 0, 1, 2, 3, 4, 5, 6, 7);
                    O[mt][0] = MFMA16(vf, pf[0], O[mt][0]);
                    O[mt][1] = MFMA16(vf, pf[1], O[mt][1]);
                }
            }
            if (more) {
                char* nb = lds + ((i + 1) & 1) * BUFB;
#pragma unroll
                for (int c = 0; c < NCH; ++c) { *(u32x4*)(nb + k_st + c * KSTEP * 128) = rk[c]; *(u32x4*)(nb + v_st + c * KSTEP * VPITCH) = rv[c]; }
            }
            __syncthreads();
        }
#pragma unroll
        for (int nt = 0; nt < 2; ++nt) {
            const float l = rows_sum(lrun[nt]);
            const float inv = __builtin_amdgcn_rcpf(l);
#pragma unroll
            for (int mt = 0; mt < MT; ++mt) O[mt][nt] = O[mt][nt] * inv;
        }
        if (DIFF) {
            float* ex = (float*)lds;
            if (sub == 1) {
#pragma unroll
                for (int nt = 0; nt < 2; ++nt)
#pragma unroll
                    for (int mt = 0; mt < MT; ++mt)
#pragma unroll
                        for (int r = 0; r < 4; ++r) ex[((qg * 2 + nt) * 32 + mt * 4 + r) * 64 + lane] = O[mt][nt][r];
            }
            __syncthreads();
            if (sub == 0) {
                const float* gs = p.diff_subln_g;
                const int h = vhead >> 1;
#pragma unroll
                for (int nt = 0; nt < 2; ++nt) {
                    float ss = 0.f;
#pragma unroll
                    for (int mt = 0; mt < MT; ++mt)
#pragma unroll
                        for (int r = 0; r < 4; ++r) {
                            const float d = O[mt][nt][r] - lam * ex[((qg * 2 + nt) * 32 + mt * 4 + r) * 64 + lane];
                            O[mt][nt][r] = d;
                            ss += d * d;
                        }
                    ss = rows_sum(ss);
                    const float rstd = rsqrtf(ss * (1.f / 128.f) + EPS) * 0.8f;
                    bf16_t* orow = obuf + (size_t)(qtok0 + qg * 32 + nt * 16 + lr) * 1024 + h * 128;
#pragma unroll
                    for (int mp = 0; mp < MT / 2; ++mp) {
                        u32x2 o[2];
#pragma unroll
                        for (int e = 0; e < 2; ++e) {
                            const int mt = 2 * mp + e;
                            const f32x4 gg = *(const f32x4*)(gs + mt * 16 + g * 4);
                            const f32x4 v = O[mt][nt] * rstd * gg;
                            o[e][0] = pack2(v[0], v[1]); o[e][1] = pack2(v[2], v[3]);
                        }
                        store_pair16(orow + mp * 32, o[0], o[1], g);
                    }
                }
            }
            __syncthreads();
        } else {
#pragma unroll
            for (int nt = 0; nt < 2; ++nt) {
                bf16_t* orow = obuf + (size_t)(qtok0 + qg * 32 + nt * 16 + lr) * 1024 + vhead * 64;
#pragma unroll
                for (int mp = 0; mp < MT / 2; ++mp) {
                    const f32x4 v0 = O[2 * mp][nt], v1 = O[2 * mp + 1][nt];
                    u32x2 a, b; a[0] = pack2(v0[0], v0[1]); a[1] = pack2(v0[2], v0[3]); b[0] = pack2(v1[0], v1[1]); b[1] = pack2(v1[2], v1[3]);
                    store_pair16(orow + mp * 32, a, b, g);
                }
            }
        }
    }
    if (DIFF && !bg_first) deferred_transposes(p, lds);
}

__global__ void __launch_bounds__(512, 2) mega(Params p) {
    extern __shared__ __attribute__((aligned(16))) char lds[];
    cg::grid_group grid = cg::this_grid();
    if (p.ws == nullptr) grid.sync();
    volatile LAS unsigned* st = (volatile LAS unsigned*)(lds + LDS_MAIN);
    if (threadIdx.x == 0) { st[0] = 0u; st[1] = 0u; st[2] = 0u; st[3] = 0u; }
    __syncthreads();
    const XcdBarrier xb = xcd_barrier_post((unsigned*)(p.ws + OFF_BAR), st);
    const bf16_t* hbuf = (const bf16_t*)(p.ws + OFF_H);
    const bf16_t* obuf = (const bf16_t*)(p.ws + OFF_O);
    const bf16_t* ubuf = (const bf16_t*)(p.ws + OFF_U);
    prepass(p, lds);
    xcd_barrier(xb);
    rowphase<0>(p, 0);
    xcd_barrier(xb);
    gemm_phase<EPI_QKV_DIFF>(p, hbuf, (const bf16_t*)(p.ws + OFF_WQKV0), 3072, 1024, lds);
    xcd_barrier(xb);
    attn_phase<true>(p, lds);
    xcd_barrier(xb);
    gemm_phase<EPI_F32>(p, obuf, (const bf16_t*)(p.ws + OFF_WO0), 1024, 1024, lds);
    xcd_barrier(xb);
    rowphase<1>(p, 0);
    xcd_barrier(xb);
    gemm_phase<EPI_GU>(p, hbuf, (const bf16_t*)(p.ws + OFF_WGU0), 5632, 1024, lds);
    xcd_barrier(xb);
    gemm_phase<EPI_F32>(p, ubuf, (const bf16_t*)(p.ws + OFF_WD0), 1024, 2816, lds);
    xcd_barrier(xb);
    rowphase<2>(p, 0);
    xcd_barrier(xb);
    gemm_phase<EPI_QKV_SWA>(p, hbuf, (const bf16_t*)(p.ws + OFF_WQKV1), 1536, 1024, lds);
    xcd_barrier(xb);
    attn_phase<false>(p, lds);
    xcd_barrier(xb);
    gemm_phase<EPI_F32>(p, obuf, (const bf16_t*)(p.ws + OFF_WO1), 1024, 1024, lds);
    xcd_barrier(xb);
    rowphase<1>(p, 1);
    xcd_barrier(xb);
    gemm_phase<EPI_GU>(p, hbuf, (const bf16_t*)(p.ws + OFF_WGU1), 5632, 1024, lds);
    xcd_barrier(xb);
    gemm_phase<EPI_F32>(p, ubuf, (const bf16_t*)(p.ws + OFF_WD1), 1024, 2816, lds);
    xcd_barrier(xb);
    rowphase<2>(p, 1);
}

extern "C" void kernel_launch(void* const* d_in, const int* in_sizes, int n_in, void* d_out, int out_size, void* d_ws, size_t ws_size, hipStream_t stream) {
    static int grid_blocks = 0;
    if (grid_blocks == 0) {
        if (n_in != 21 || ws_size < WS_END) { fprintf(stderr, "kernel_launch: unexpected inputs (n_in %d, ws %zu < %zu)\n", n_in, ws_size, (size_t)WS_END); grid_blocks = -1; return; }
        int dev = 0, cus = 0, per_cu = 0;
        (void)hipGetDevice(&dev);
        (void)hipDeviceGetAttribute(&cus, hipDeviceAttributeMultiprocessorCount, dev);
        if (hipFuncSetAttribute((const void*)mega, hipFuncAttributeMaxDynamicSharedMemorySize, LDS_BYTES) != hipSuccess) { fprintf(stderr, "kernel_launch: hipFuncSetAttribute failed\n"); grid_blocks = -1; return; }
        if (hipOccupancyMaxActiveBlocksPerMultiprocessor(&per_cu, (const void*)mega, NTHR, LDS_BYTES) != hipSuccess || per_cu < 1) { fprintf(stderr, "kernel_launch: occupancy query failed (%d)\n", per_cu); grid_blocks = -1; return; }
        if (per_cu > 1) per_cu = 1;
        grid_blocks = cus * per_cu;
        fprintf(stderr, "kernel_launch: %d CUs x %d = %d workgroups\n", cus, per_cu, grid_blocks);
    }
    if (grid_blocks < 0) return;
    if (hipMemsetAsync((char*)d_ws + OFF_BAR, 0, XCD_BAR_WORDS * 4, stream) != hipSuccess) { fprintf(stderr, "kernel_launch: memset failed\n"); return; }
    Params p{};
    const float** pp = (const float**)&p;
    for (int i = 0; i < 21; ++i) pp[i] = (const float*)d_in[i];
    p.out = (float*)d_out;
    p.ws = (char*)d_ws;
    void* args[] = {&p};
    hipError_t e = hipLaunchCooperativeKernel((const void*)mega, dim3(grid_blocks), dim3(NTHR), args, LDS_BYTES, stream);
    if (e != hipSuccess) fprintf(stderr, "cooperative launch failed: %s (grid %d)\n", hipGetErrorString(e), grid_blocks);
}
```

```cpp
#include <hip/hip_runtime.h>
#include <hip/hip_cooperative_groups.h>
#include <cstdint>
#include <cstdio>
namespace cg = cooperative_groups;

typedef unsigned short bf16_t;
typedef short bf16x8 __attribute__((ext_vector_type(8)));
typedef short s16x4 __attribute__((ext_vector_type(4)));
typedef float f32x4 __attribute__((ext_vector_type(4)));
typedef float f32x2 __attribute__((ext_vector_type(2)));
typedef unsigned u32x4 __attribute__((ext_vector_type(4)));
typedef unsigned u32x2 __attribute__((ext_vector_type(2)));
typedef __bf16 bf2_t __attribute__((ext_vector_type(2)));
#define DI __device__ __forceinline__
#define MFMA16(a, b, c) __builtin_amdgcn_mfma_f32_16x16x32_bf16((a), (b), (c), 0, 0, 0)

constexpr int D = 1024, NTOK = 8192, NPROMPT = 4096, DFF = 2816;
constexpr float EPS = 1e-6f, LOG2E = 1.4426950408889634f, SC = 0.125f * 1.4426950408889634f;

constexpr size_t OFF_MOD = 0;
constexpr size_t OFF_ROPE = 147456;
constexpr size_t OFF_BAR = 163840;
constexpr size_t OFF_WQKV0 = 1u << 20;
constexpr size_t OFF_WO0 = OFF_WQKV0 + 3072ull * 1024 * 2;
constexpr size_t OFF_WGU0 = OFF_WO0 + 1024ull * 1024 * 2;
constexpr size_t OFF_WD0 = OFF_WGU0 + 5632ull * 1024 * 2;
constexpr size_t OFF_WQKV1 = OFF_WD0 + 1024ull * 2816 * 2;
constexpr size_t OFF_WO1 = OFF_WQKV1 + 1536ull * 1024 * 2;
constexpr size_t OFF_WGU1 = OFF_WO1 + 1024ull * 1024 * 2;
constexpr size_t OFF_WD1 = OFF_WGU1 + 5632ull * 1024 * 2;
constexpr size_t OFF_CKD = OFF_WD1 + 1024ull * 2816 * 2;
constexpr size_t OFF_CVD = OFF_CKD + 1024ull * 1024 * 2;
constexpr size_t OFF_CKS = OFF_CVD + 1024ull * 1024 * 2;
constexpr size_t OFF_CVS = OFF_CKS + 1024ull * 256 * 2;
constexpr size_t OFF_H = OFF_CVS + 1024ull * 256 * 2;
constexpr size_t OFF_Q = OFF_H + 8192ull * 1024 * 2;
constexpr size_t OFF_K = OFF_Q + 8192ull * 1024 * 2;
constexpr size_t OFF_V = OFF_K + 8192ull * 1024 * 2;
constexpr size_t OFF_U = OFF_Q;
constexpr size_t OFF_O = OFF_V + 8192ull * 1024 * 2;
constexpr size_t OFF_Y = OFF_O + 8192ull * 1024 * 2;
constexpr size_t OFF_X = OFF_Y + 8192ull * 1024 * 4;
constexpr size_t WS_END = OFF_X + 8192ull * 1024 * 4;
static_assert(8192ull * 2816 * 2 <= 3 * 8192ull * 1024 * 2, "U overlay");

constexpr size_t OUT_Y = 0, OUT_NDK = 8388608, OUT_NDV = 12582912, OUT_NSK = 16777216, OUT_NSV = 17825792;

constexpr int NTHR = 512, NWAVE = 8;
constexpr int LDS_MAIN = 147456, LDS_BYTES = LDS_MAIN + 16;

struct Params {
    const float *x_prompt, *x_sample, *cdk, *cdv, *csk, *csv, *c, *c_ctx, *w_mod, *b_mod, *norm_g, *w_qkv_diff, *diff_lambda, *diff_subln_g,
        *w_o_diff, *w_qkv_swa, *swa_sink, *w_o_swa, *w_gate, *w_up, *w_down;
    float* out;
    char* ws;
};

DI unsigned pack2(float a, float b) { bf2_t v; v[0] = (__bf16)a; v[1] = (__bf16)b; return __builtin_bit_cast(unsigned, v); }
DI float wave_sum(float v) {
#pragma unroll
    for (int o = 32; o > 0; o >>= 1) v += __shfl_xor(v, o);
    return v;
}
DI float rows_max(float v) {
    auto a = __builtin_amdgcn_permlane16_swap(__float_as_uint(v), __float_as_uint(v), false, false);
    v = fmaxf(__uint_as_float(a[0]), __uint_as_float(a[1]));
    auto b = __builtin_amdgcn_permlane32_swap(__float_as_uint(v), __float_as_uint(v), false, false);
    return fmaxf(__uint_as_float(b[0]), __uint_as_float(b[1]));
}
DI float rows_sum(float v) {
    auto a = __builtin_amdgcn_permlane16_swap(__float_as_uint(v), __float_as_uint(v), false, false);
    v = __uint_as_float(a[0]) + __uint_as_float(a[1]);
    auto b = __builtin_amdgcn_permlane32_swap(__float_as_uint(v), __float_as_uint(v), false, false);
    return __uint_as_float(b[0]) + __uint_as_float(b[1]);
}
DI float silu_f(float x) { return x * __builtin_amdgcn_rcpf(1.f + __expf(-x)); }


#define XB_TMO      128
#define XB_XCNT(j)  (256  + 64 * (j))
#define XB_XSUB(j)  (1280 + 64 * (j))
#define XB_XGEN(j)  (2304 + 64 * (j))
#define XB_TOP      3328
#define XB_TOPGEN   3392
#define XCD_BAR_WORDS 3456
#define XB_SPIN_CAP (1u << 18)
#define LAS __attribute__((address_space(3)))
DI unsigned xb_ld(unsigned* p) { return __hip_atomic_load(p, __ATOMIC_RELAXED, __HIP_MEMORY_SCOPE_AGENT); }
DI unsigned xb_add(unsigned* p, unsigned v) { return __hip_atomic_fetch_add(p, v, __ATOMIC_RELAXED, __HIP_MEMORY_SCOPE_AGENT); }
DI unsigned xb_xcc_id() { return (unsigned)__builtin_amdgcn_s_getreg((3 << 11) | 20) & 0xFu; }
#define XB_SPIN(cond, bar) do { unsigned _sp = 0; while (cond) { __builtin_amdgcn_s_sleep(1); \
    if ((++_sp & 255u) == 0u) { if (xb_ld(&(bar)[XB_TMO])) break; if (_sp > XB_SPIN_CAP) { atomicAdd(&(bar)[XB_TMO], 1u); break; } } } } while (0)
struct XcdBarrier { unsigned* bar; unsigned x; volatile LAS unsigned* st; };
DI XcdBarrier xcd_barrier_post(unsigned* bar, volatile LAS unsigned* st) {
    XcdBarrier b; b.bar = bar; b.x = xb_xcc_id(); b.st = st;
    if (threadIdx.x == 0) (void)xb_add(&bar[XB_XCNT(b.x)], 1u);
    return b;
}
DI void xcd_barrier_complete(unsigned* bar, unsigned x, unsigned& nloc, unsigned& nx) {
    const unsigned G = gridDim.x * gridDim.y * gridDim.z;
    unsigned sum, cnt, mine, sp = 0u;
    for (;;) {
        sum = 0u; cnt = 0u; mine = 0u;
#pragma unroll
        for (unsigned j = 0; j < 16; ++j) { const unsigned c = xb_ld(&bar[XB_XCNT(j)]); sum += c; cnt += (c > 0u) ? 1u : 0u; mine = (j == x) ? c : mine; }
        if (sum == G) break;
        __builtin_amdgcn_s_sleep(1);
        if ((++sp & 255u) == 0u) { if (xb_ld(&bar[XB_TMO])) break; if (sp > XB_SPIN_CAP) { atomicAdd(&bar[XB_TMO], 1u); break; } }
    }
    nloc = mine > 0u ? mine : 1u; nx = cnt > 0u ? cnt : 1u;
}
DI void xcd_barrier(const XcdBarrier& b) {
    asm volatile("s_waitcnt vmcnt(0)" ::: "memory");
    __syncthreads();
    if (threadIdx.x == 0) {
        unsigned* bar = b.bar;
        __builtin_amdgcn_s_waitcnt(0);
        unsigned nloc = b.st[0], nx = b.st[1];
        if (nloc == 0u) { xcd_barrier_complete(bar, b.x, nloc, nx); b.st[0] = nloc; b.st[1] = nx; }
        const unsigned old = xb_add(&bar[XB_XSUB(b.x)], 1u);
        const unsigned gen = old / nloc;
        if (old + 1u == (gen + 1u) * nloc) {
            __builtin_amdgcn_fence(__ATOMIC_RELEASE, "agent");
            asm volatile("s_waitcnt vmcnt(0)" ::: "memory");
            const unsigned og = xb_add(&bar[XB_TOP], 1u);
            const unsigned tg = og / nx;
            if (og + 1u == (tg + 1u) * nx) xb_add(&bar[XB_TOPGEN], 1u);
            else XB_SPIN(xb_ld(&bar[XB_TOPGEN]) == tg, bar);
            __builtin_amdgcn_fence(__ATOMIC_ACQUIRE, "agent");
            xb_add(&bar[XB_XGEN(b.x)], 1u);
            asm volatile("s_waitcnt vmcnt(0)" ::: "memory");
        } else {
            XB_SPIN(xb_ld(&bar[XB_XGEN(b.x)]) == gen, bar);
            __builtin_amdgcn_fence(__ATOMIC_ACQUIRE, "agent");
            asm volatile("s_waitcnt vmcnt(0)" ::: "memory");
        }
    }
    __syncthreads();
}

DI void transpose_item_wave(const float* __restrict__ src, int ld, int k0, int c0, bf16_t* __restrict__ dst, int K, int nrow0, float* scr, int lane) {
#pragma unroll 8
    for (int i = 0; i < 32; ++i) { const int kk = 2 * i + (lane >> 5); scr[kk * 33 + (lane & 31)] = src[(size_t)(k0 + kk) * ld + c0 + (lane & 31)]; }
    asm volatile("s_waitcnt lgkmcnt(0)" ::: "memory");
    const int c = lane & 7;
#pragma unroll
    for (int j = 0; j < 4; ++j) {
        const int n = (lane >> 3) + 8 * j;
        const float* r = scr + (8 * c) * 33 + n;
        u32x4 o;
        o[0] = pack2(r[0 * 33], r[1 * 33]); o[1] = pack2(r[2 * 33], r[3 * 33]); o[2] = pack2(r[4 * 33], r[5 * 33]); o[3] = pack2(r[6 * 33], r[7 * 33]);
        *(u32x4*)(dst + (size_t)(nrow0 + n) * K + k0 + 8 * c) = o;
    }
    asm volatile("s_waitcnt lgkmcnt(0)" ::: "memory");
}

DI void tr_block_item(const Params& p, int bi, char* lds) {
    const int tid = threadIdx.x;
    int ti = bi * NWAVE + (tid >> 6);
    const int l = ti >= 6272 ? 1 : 0; ti -= l * 6272;
    const int nq = l ? 1536 : 3072, i_qkv = 16 * (nq / 32);
    const float* src; const float* src2 = nullptr; int ld, K; bf16_t* dst; bool gu = false;
    if (ti < i_qkv) { src = l ? p.w_qkv_swa : p.w_qkv_diff; ld = nq; K = 1024; dst = (bf16_t*)(p.ws + (l ? OFF_WQKV1 : OFF_WQKV0)); }
    else if ((ti -= i_qkv) < 512) { src = l ? p.w_o_swa : p.w_o_diff; ld = 1024; K = 1024; dst = (bf16_t*)(p.ws + (l ? OFF_WO1 : OFF_WO0)); }
    else if ((ti -= 512) < 2816) { src = p.w_gate + (size_t)l * 1024 * 2816; src2 = p.w_up + (size_t)l * 1024 * 2816; ld = 2816; K = 1024; dst = (bf16_t*)(p.ws + (l ? OFF_WGU1 : OFF_WGU0)); gu = true; }
    else { ti -= 2816; src = p.w_down + (size_t)l * 2816 * 1024; ld = 1024; K = 2816; dst = (bf16_t*)(p.ws + (l ? OFF_WD1 : OFF_WD0)); }
    const int nkb = K / 64, kb = ti % nkb, nb = ti / nkb;
    int c0 = nb * 32;
    if (gu) { const int tile = nb >> 2, wc = (nb >> 1) & 1, isup = nb & 1; c0 = tile * 64 + wc * 32; if (isup) src = src2; }
    transpose_item_wave(src, ld, kb * 64, c0, dst, K, nb * 32, (float*)lds + (tid >> 6) * (64 * 33), tid & 63);
}
constexpr int TR_P0 = 192, TR_ALL = 1472;
__device__ void deferred_transposes(const Params& p, char* lds) {
    __syncthreads();
    for (int bi = TR_P0 + blockIdx.x; bi < TR_ALL; bi += gridDim.x) tr_block_item(p, bi, lds);
    __syncthreads();
}

__device__ void prepass(const Params& p, char* lds) {
    const int tid = threadIdx.x;
    constexpr int N_MOD = 192, N_ROPE = 2, N_TR = TR_P0, N_CACHE = 640;
    constexpr int TOTAL = N_MOD + N_ROPE + N_TR + N_CACHE;
    for (int it = blockIdx.x; it < TOTAL; it += gridDim.x) {
        if (it < N_MOD) {
            const int l = it / 96, n0 = (it % 96) * 64;
            float* sc = (float*)lds;
            float* red = sc + 3 * 1024;
            for (int e = tid; e < 3 * 1024; e += NTHR) {
                const int c = e >> 10, k = e & 1023;
                const float v = (c == 0) ? p.c_ctx[k] : p.c[(c - 1) * 1024 + k];
                sc[e] = silu_f(v);
            }
            __syncthreads();
            const int c4 = tid & 15, kg = tid >> 4;
            const float* w = p.w_mod + (size_t)l * 1024 * 6144 + (size_t)(kg * 32) * 6144 + n0 + c4 * 4;
            f32x4 a0 = {0.f, 0.f, 0.f, 0.f}, a1 = a0, a2 = a0;
#pragma unroll 8
            for (int k = 0; k < 32; ++k) {
                const f32x4 wv = *(const f32x4*)(w + (size_t)k * 6144);
                a0 += wv * sc[kg * 32 + k]; a1 += wv * sc[1024 + kg * 32 + k]; a2 += wv * sc[2048 + kg * 32 + k];
            }
            *(f32x4*)(red + (kg * 3 + 0) * 64 + c4 * 4) = a0; *(f32x4*)(red + (kg * 3 + 1) * 64 + c4 * 4) = a1; *(f32x4*)(red + (kg * 3 + 2) * 64 + c4 * 4) = a2;
            __syncthreads();
            if (tid < 192) {
                const int c = tid >> 6, cc = tid & 63;
                float s = p.b_mod[l * 6144 + n0 + cc];
#pragma unroll
                for (int q = 0; q < 32; ++q) s += red[(q * 3 + c) * 64 + cc];
                ((float*)(p.ws + OFF_MOD))[(l * 3 + c) * 6144 + n0 + cc] = s;
            }
            __syncthreads();
        } else if (it < N_MOD + N_ROPE) {
            float* rt = (float*)(p.ws + OFF_ROPE);
            const int e = (it - N_MOD) * NTHR + tid;
            const int pos = e >> 4, i = e & 15;
            const float inv = (float)exp2(-((double)i / 16.0) * 13.287712379549449);
            const float ang = (float)pos * inv;
            rt[e * 2] = (float)cos((double)ang);
            rt[e * 2 + 1] = (float)sin((double)ang);
        } else if (it < N_MOD + N_ROPE + N_TR) {
            tr_block_item(p, it - (N_MOD + N_ROPE), lds);
        } else {
            int ci = it - (N_MOD + N_ROPE + N_TR);
            const float* src; bf16_t* dst;
            if (ci < 256) { src = p.cdk; dst = (bf16_t*)(p.ws + OFF_CKD); }
            else if (ci < 512) { src = p.cdv; dst = (bf16_t*)(p.ws + OFF_CVD); ci -= 256; }
            else if (ci < 576) { src = p.csk; dst = (bf16_t*)(p.ws + OFF_CKS); ci -= 512; }
            else { src = p.csv; dst = (bf16_t*)(p.ws + OFF_CVS); ci -= 576; }
            const size_t e = (size_t)ci * 4096 + tid * 8;
            const f32x4 a = *(const f32x4*)(src + e), b = *(const f32x4*)(src + e + 4);
            u32x4 o; o[0] = pack2(a[0], a[1]); o[1] = pack2(a[2], a[3]); o[2] = pack2(b[0], b[1]); o[3] = pack2(b[2], b[3]);
            *(u32x4*)(dst + e) = o;
        }
    }
}

DI void bf8_to_f32(const u32x4 r, f32x4& a, f32x4& b) {
    a = (f32x4){__uint_as_float(r[0] << 16), __uint_as_float(r[0] & 0xffff0000u), __uint_as_float(r[1] << 16), __uint_as_float(r[1] & 0xffff0000u)};
    b = (f32x4){__uint_as_float(r[2] << 16), __uint_as_float(r[2] & 0xffff0000u), __uint_as_float(r[3] << 16), __uint_as_float(r[3] & 0xffff0000u)};
}
DI u32x4 f32_to_bf8(const f32x4 a, const f32x4 b) { u32x4 o; o[0] = pack2(a[0], a[1]); o[1] = pack2(a[2], a[3]); o[2] = pack2(b[0], b[1]); o[3] = pack2(b[2], b[3]); return o; }

template <int MODE>
__device__ void rowphase(const Params& p, int layer) {
    const int lane = threadIdx.x & 63, w = threadIdx.x >> 6;
    const float* mod = (const float*)(p.ws + OFF_MOD);
    bf16_t* xbuf = (bf16_t*)(p.ws + OFF_X);
    const bf16_t* ybuf = (const bf16_t*)(p.ws + OFF_Y);
    bf16_t* hbuf = (bf16_t*)(p.ws + OFF_H);
    constexpr int RB = 4;
    const bool last = (MODE == 2 && layer == 1);
    for (int rb = blockIdx.x * NWAVE + w; rb < NTOK / RB; rb += gridDim.x * NWAVE) {
        const int rowb = rb * RB;
        const int cond = rowb < NPROMPT ? 0 : 1 + ((rowb - NPROMPT) >> 11);
        const float* mrow = mod + (size_t)(layer * 3 + cond) * 6144;
        const int nl = (MODE == 2) ? layer + 1 : layer;
        const float* mrow2 = mod + (size_t)(nl * 3 + cond) * 6144;
        f32x4 vgpost[4], vgate[4], vgpre[4], vshift[4], vscale[4];
#pragma unroll
        for (int q = 0; q < 4; ++q) {
            const int o = (q >> 1) * 512 + lane * 8 + (q & 1) * 4;
            if (MODE != 0) {
                vgpost[q] = *(const f32x4*)(p.norm_g + (size_t)(layer * 4 + (MODE == 1 ? 1 : 3)) * D + o);
                vgate[q] = *(const f32x4*)(mrow + (MODE == 1 ? 2 : 5) * D + o);
            }
            if (!last) {
                vgpre[q] = *(const f32x4*)(p.norm_g + (size_t)(nl * 4 + (MODE == 1 ? 2 : 0)) * D + o);
                vshift[q] = *(const f32x4*)(mrow2 + (MODE == 1 ? 3 : 0) * D + o);
                vscale[q] = *(const f32x4*)(mrow2 + (MODE == 1 ? 4 : 1) * D + o) + 1.f;
            }
        }
#pragma unroll 2
        for (int j = 0; j < RB; ++j) {
            const int row = rowb + j;
            f32x4 x[4];
            if (MODE == 2 || layer == 1) {
#pragma unroll
                for (int i = 0; i < 2; ++i) bf8_to_f32(*(const u32x4*)(xbuf + (size_t)row * D + i * 512 + lane * 8), x[2 * i], x[2 * i + 1]);
            } else {
                const float* xin = row < NPROMPT ? p.x_prompt + (size_t)row * D : p.x_sample + (size_t)(row - NPROMPT) * D;
#pragma unroll
                for (int q = 0; q < 4; ++q) x[q] = *(const f32x4*)(xin + (q >> 1) * 512 + lane * 8 + (q & 1) * 4);
            }
            if (MODE != 0) {
                f32x4 y[4];
                float ss = 0.f;
#pragma unroll
                for (int i = 0; i < 2; ++i) bf8_to_f32(*(const u32x4*)(ybuf + (size_t)row * D + i * 512 + lane * 8), y[2 * i], y[2 * i + 1]);
#pragma unroll
                for (int q = 0; q < 4; ++q) ss += y[q][0] * y[q][0] + y[q][1] * y[q][1] + y[q][2] * y[q][2] + y[q][3] * y[q][3];
                ss = wave_sum(ss);
                const float rstd = rsqrtf(ss * (1.f / D) + EPS);
#pragma unroll
                for (int q = 0; q < 4; ++q) x[q] = x[q] + vgate[q] * (y[q] * rstd * vgpost[q]);
#pragma unroll
                for (int i = 0; i < 2; ++i) {
                    if (last) {
                        *(f32x4*)(p.out + OUT_Y + (size_t)row * D + i * 512 + lane * 8) = x[2 * i];
                        *(f32x4*)(p.out + OUT_Y + (size_t)row * D + i * 512 + lane * 8 + 4) = x[2 * i + 1];
                    } else *(u32x4*)(xbuf + (size_t)row * D + i * 512 + lane * 8) = f32_to_bf8(x[2 * i], x[2 * i + 1]);
                }
            }
            if (last) continue;
            float ss = 0.f;
#pragma unroll
            for (int q = 0; q < 4; ++q) ss += x[q][0] * x[q][0] + x[q][1] * x[q][1] + x[q][2] * x[q][2] + x[q][3] * x[q][3];
            ss = wave_sum(ss);
            const float rstd = rsqrtf(ss * (1.f / D) + EPS);
#pragma unroll
            for (int i = 0; i < 2; ++i) {
                const f32x4 h0 = (x[2 * i] * rstd * vgpre[2 * i]) * vscale[2 * i] + vshift[2 * i];
                const f32x4 h1 = (x[2 * i + 1] * rstd * vgpre[2 * i + 1]) * vscale[2 * i + 1] + vshift[2 * i + 1];
                *(u32x4*)(hbuf + (size_t)row * D + i * 512 + lane * 8) = f32_to_bf8(h0, h1);
            }
        }
    }
}

DI void store_pair16(bf16_t* rowp, u32x2 A, u32x2 B, int g) {
    auto r0 = __builtin_amdgcn_permlane16_swap(A[0], B[0], false, false);
    auto r1 = __builtin_amdgcn_permlane16_swap(A[1], B[1], false, false);
    u32x4 o; o[0] = r0[0]; o[1] = r1[0]; o[2] = r0[1]; o[3] = r1[1];
    *(u32x4*)(rowp + ((g & 1) ? 16 + (g - 1) * 4 : g * 4)) = o;
}
enum { EPI_F32 = 0, EPI_QKV_DIFF = 1, EPI_QKV_SWA = 2, EPI_GU = 3 };

template <int EPI>
__device__ void gemm_phase(const Params& p, const bf16_t* __restrict__ A, const bf16_t* __restrict__ Bt, const int N, const int K, char* lds) {
    const int tid = threadIdx.x, lane = tid & 63, w = __builtin_amdgcn_readfirstlane(tid >> 6), wr = w >> 1, wc = w & 1, lr = lane & 15, g = lane >> 4;
    const int nN = N >> 7, ntiles = 32 * nN, nk = K >> 6;
    const int rin = lane >> 3, chp = lane & 7;
    const unsigned loffE = (unsigned)(rin * K + ((chp ^ (rin >> 1)) << 3)) * 2u;
    const unsigned loffO = (unsigned)(rin * K + ((chp ^ (rin >> 1) ^ 4) << 3)) * 2u;
    const int fsw = lr >> 1;
    const int half = w >> 2;
#define GEMM_STAGE(ga_, gb_, kt_, buf_) do { \
        char* _d = lds + (buf_) * 49152; \
        const size_t _k = (size_t)(kt_) * 64; \
        unsigned _lE = loffE, _lO = loffO; asm volatile("" : "+v"(_lE), "+v"(_lO)); \
        _Pragma("unroll") for (int _i = 0; _i < 4; ++_i) { \
            const char* _b = (const char*)((ga_) + (size_t)(w * 32 + _i * 8) * K + _k); \
            __builtin_amdgcn_global_load_lds((const unsigned*)(_b + ((_i & 1) ? _lO : _lE)), (__attribute__((address_space(3))) unsigned*)(_d + w * 4096 + _i * 1024), 16, 0, 0); } \
        _Pragma("unroll") for (int _i = 0; _i < 2; ++_i) { \
            const char* _b = (const char*)((gb_) + (size_t)(w * 16 + _i * 8) * K + _k); \
            __builtin_amdgcn_global_load_lds((const unsigned*)(_b + ((_i & 1) ? _lO : _lE)), (__attribute__((address_space(3))) unsigned*)(_d + 32768 + w * 2048 + _i * 1024), 16, 0, 0); } \
    } while (0)
#define GEMM_PIECE(ga_, gb_, kt_, buf_, pc_) do { \
        char* _d = lds + (buf_) * 49152; \
        const size_t _k = (size_t)(kt_) * 64; \
        unsigned _l = ((pc_) & 1) ? loffO : loffE; asm volatile("" : "+v"(_l)); \
        if ((pc_) < 4) { const char* _b = (const char*)((ga_) + (size_t)(w * 32 + (pc_) * 8) * K + _k); \
            __builtin_amdgcn_global_load_lds((const unsigned*)(_b + _l), (__attribute__((address_space(3))) unsigned*)(_d + w * 4096 + (pc_) * 1024), 16, 0, 0); } \
        else { const char* _b = (const char*)((gb_) + (size_t)(w * 16 + ((pc_) - 4) * 8) * K + _k); \
            __builtin_amdgcn_global_load_lds((const unsigned*)(_b + _l), (__attribute__((address_space(3))) unsigned*)(_d + 32768 + w * 2048 + ((pc_) - 4) * 1024), 16, 0, 0); } \
    } while (0)
    int t = blockIdx.x;
    if (t >= ntiles) return;
    int cur = 0;
    {
        const bf16_t* ga = A + (size_t)((t & 31) * 256) * K;
        const bf16_t* gb = Bt + (size_t)((t >> 5) * 128) * K;
        __syncthreads();
        GEMM_STAGE(ga, gb, 0, 0);
        GEMM_STAGE(ga, gb, 1, 1);
    }
    bool first = true;
    for (; t < ntiles; t += gridDim.x) {
        const int pm = t & 31, pn = t >> 5;
        const int m0 = pm * 256, n0 = pn * 128;
        f32x4 acc[4][4];
#pragma unroll
        for (int i = 0; i < 4; ++i)
#pragma unroll
            for (int j = 0; j < 4; ++j) acc[i][j] = (f32x4){0.f, 0.f, 0.f, 0.f};
        const bf16_t* ga = A + (size_t)m0 * K;
        const bf16_t* gb = Bt + (size_t)n0 * K;
        const int tn = t + gridDim.x;
        const bool has_next = tn < ntiles;
        const bf16_t* ga2 = A + (size_t)((tn & 31) * 256) * K;
        const bf16_t* gb2 = Bt + (size_t)((tn >> 5) * 128) * K;
        bf16x8 af[2][4], bfr[2][4];
#define GEMM_READ() do { \
            _Pragma("unroll") for (int ks = 0; ks < 2; ++ks) { \
                const int coff = ((ks * 4 + g) ^ fsw) << 4; \
                _Pragma("unroll") for (int mt = 0; mt < 4; ++mt) af[ks][mt] = *(const bf16x8*)(sa + (wr * 64 + mt * 16 + lr) * 128 + coff); \
                _Pragma("unroll") for (int nt = 0; nt < 4; ++nt) bfr[ks][nt] = *(const bf16x8*)(sb + (wc * 64 + nt * 16 + lr) * 128 + coff); \
            } } while (0)
#define GEMM_MMA() do { \
            _Pragma("unroll") for (int ks = 0; ks < 2; ++ks) \
                _Pragma("unroll") for (int mt = 0; mt < 4; ++mt) \
                    _Pragma("unroll") for (int nt = 0; nt < 4; ++nt) acc[mt][nt] = MFMA16(bfr[ks][nt], af[ks][mt], acc[mt][nt]); \
            } while (0)
#define GEMM_MMA_DMA(kt_) do { \
            const int slot2 = (cur == 0) ? 2 : cur - 1; \
            const bool _own = (kt_) + 2 < nk; const bool _any = _own || has_next; \
            const bf16_t* _ga = _own ? ga : ga2; const bf16_t* _gb = _own ? gb : gb2; const int _kk = _own ? (kt_) + 2 : (kt_) + 2 - nk; \
            _Pragma("unroll") for (int ks = 0; ks < 2; ++ks) \
                _Pragma("unroll") for (int mt = 0; mt < 4; ++mt) { \
                    _Pragma("unroll") for (int nt = 0; nt < 4; ++nt) acc[mt][nt] = MFMA16(bfr[ks][nt], af[ks][mt], acc[mt][nt]); \
                    const int _g = ks * 4 + mt; \
                    if ((_g == 1 || _g == 3 || _g == 5) && _any) { __builtin_amdgcn_sched_barrier(0); GEMM_PIECE(_ga, _gb, _kk, slot2, (_g - 1) >> 1); __builtin_amdgcn_sched_barrier(0); } \
                } \
            } while (0)
#define GEMM_SLOT_A(kt_) do { \
            if ((kt_) == 0) { if (first) asm volatile("s_waitcnt vmcnt(6) lgkmcnt(0)" ::: "memory"); else asm volatile("s_waitcnt lgkmcnt(0)" ::: "memory"); } \
            else if ((kt_) + 1 < nk || has_next) asm volatile("s_waitcnt vmcnt(6) lgkmcnt(0)" ::: "memory"); \
            else asm volatile("s_waitcnt vmcnt(0) lgkmcnt(0)" ::: "memory"); \
            __builtin_amdgcn_sched_barrier(0); __builtin_amdgcn_s_barrier(); __builtin_amdgcn_sched_barrier(0); \
            asm volatile("" ::: "memory"); \
        } while (0)
#define GEMM_MID_BAR() do { \
            asm volatile("s_waitcnt lgkmcnt(0)" ::: "memory"); \
            __builtin_amdgcn_sched_barrier(0); __builtin_amdgcn_s_barrier(); __builtin_amdgcn_sched_barrier(0); \
            asm volatile("" ::: "memory"); \
        } while (0)
#define GEMM_REST(kt_) do { \
            asm volatile("s_waitcnt lgkmcnt(0)" ::: "memory"); \
            __builtin_amdgcn_sched_barrier(0); \
            const int slot2 = (cur == 0) ? 2 : cur - 1; \
            const bool _own = (kt_) + 2 < nk; \
            if (_own || has_next) { \
                const bf16_t* _ga = _own ? ga : ga2; const bf16_t* _gb = _own ? gb : gb2; const int _kk = _own ? (kt_) + 2 : (kt_) + 2 - nk; \
                GEMM_PIECE(_ga, _gb, _kk, slot2, 3); GEMM_PIECE(_ga, _gb, _kk, slot2, 4); GEMM_PIECE(_ga, _gb, _kk, slot2, 5); } \
            __builtin_amdgcn_sched_barrier(0); \
        } while (0)
        if (half == 0) {
            for (int kt = 0; kt < nk; ++kt) {
                GEMM_SLOT_A(kt);
                const char* sa = lds + cur * 49152;
                const char* sb = sa + 32768;
                GEMM_READ();
                GEMM_REST(kt);
                GEMM_MID_BAR();
                GEMM_MMA_DMA(kt);
                cur = (cur == 2) ? 0 : cur + 1;
            }
        } else {
            for (int kt = 0; kt < nk; ++kt) {
                GEMM_SLOT_A(kt);
                if (kt > 0) GEMM_MMA_DMA(kt);
                else { const int slot2 = (cur == 0) ? 2 : cur - 1; GEMM_PIECE(ga, gb, 2, slot2, 0); GEMM_PIECE(ga, gb, 2, slot2, 1); GEMM_PIECE(ga, gb, 2, slot2, 2); }
                GEMM_MID_BAR();
                const char* sa = lds + cur * 49152;
                const char* sb = sa + 32768;
                GEMM_READ();
                GEMM_REST(kt);
                cur = (cur == 2) ? 0 : cur + 1;
            }
            asm volatile("s_waitcnt lgkmcnt(0)" ::: "memory");
            GEMM_MMA();
        }
#undef GEMM_REST
#undef GEMM_SLOT_A
#undef GEMM_MID_BAR
        if (has_next) asm volatile("s_waitcnt vmcnt(6)" ::: "memory");
        first = false;
#undef GEMM_READ
#undef GEMM_MMA
#undef GEMM_MMA_DMA
        const int mbase = m0 + wr * 64 + lr;
        const int nbase = n0 + wc * 64 + g * 4;
        if (EPI == EPI_F32) {
            bf16_t* Y = (bf16_t*)(p.ws + OFF_Y);
#pragma unroll
            for (int mt = 0; mt < 4; ++mt)
#pragma unroll
                for (int np = 0; np < 2; ++np) {
                    const f32x4 v0 = acc[mt][2 * np], v1 = acc[mt][2 * np + 1];
                    u32x2 a, b; a[0] = pack2(v0[0], v0[1]); a[1] = pack2(v0[2], v0[3]); b[0] = pack2(v1[0], v1[1]); b[1] = pack2(v1[2], v1[3]);
                    store_pair16(Y + (size_t)(mbase + mt * 16) * N + n0 + wc * 64 + np * 32, a, b, g);
                }
        } else if (EPI == EPI_GU) {
            bf16_t* U = (bf16_t*)(p.ws + OFF_U);
#pragma unroll
            for (int mt = 0; mt < 4; ++mt) {
                u32x2 o[2];
#pragma unroll
                for (int nt = 0; nt < 2; ++nt) {
                    const f32x4 gt = acc[mt][nt], up = acc[mt][nt + 2];
                    o[nt][0] = pack2(silu_f(gt[0]) * up[0], silu_f(gt[1]) * up[1]);
                    o[nt][1] = pack2(silu_f(gt[2]) * up[2], silu_f(gt[3]) * up[3]);
                }
                store_pair16(U + (size_t)(mbase + mt * 16) * DFF + pn * 64 + wc * 32, o[0], o[1], g);
            }
        } else {
            const int ncol0 = n0 + wc * 64;
            int sec, cofs, pitch;
            if (EPI == EPI_QKV_DIFF) { sec = ncol0 >> 10; cofs = ncol0 & 1023; pitch = 1024; }
            else { sec = ncol0 < 1024 ? 0 : (ncol0 < 1280 ? 1 : 2); cofs = sec == 0 ? ncol0 : (sec == 1 ? ncol0 - 1024 : ncol0 - 1280); pitch = sec == 0 ? 1024 : 256; }
            const bool latent = m0 >= NPROMPT;
            if (latent && sec < 2) {
                const float* rt = (const float*)(p.ws + OFF_ROPE);
#pragma unroll
                for (int mt = 0; mt < 4; ++mt) {
                    const int tl = (mbase + mt * 16 - NPROMPT) & 2047;
                    const int prow = tl >> 6, pcol = tl & 63;
                    const f32x4 r0 = *(const f32x4*)(rt + (prow * 16 + g * 4) * 2), r1 = *(const f32x4*)(rt + (prow * 16 + g * 4) * 2 + 4);
                    const f32x4 c0 = *(const f32x4*)(rt + (pcol * 16 + g * 4) * 2), c1 = *(const f32x4*)(rt + (pcol * 16 + g * 4) * 2 + 4);
                    const float cr[4] = {r0[0], r0[2], r1[0], r1[2]}, sr[4] = {r0[1], r0[3], r1[1], r1[3]};
                    const float cc[4] = {c0[0], c0[2], c1[0], c1[2]}, sc[4] = {c0[1], c0[3], c1[1], c1[3]};
#pragma unroll
                    for (int r = 0; r < 4; ++r) {
                        const float x1 = acc[mt][0][r], x2 = acc[mt][1][r], x3 = acc[mt][2][r], x4 = acc[mt][3][r];
                        acc[mt][0][r] = x1 * cr[r] - x2 * sr[r];
                        acc[mt][1][r] = x2 * cr[r] + x1 * sr[r];
                        acc[mt][2][r] = x3 * cc[r] - x4 * sc[r];
                        acc[mt][3][r] = x4 * cc[r] + x3 * sc[r];
                    }
                }
            }
            bf16_t* dstb = (bf16_t*)(p.ws + (sec == 0 ? OFF_Q : (sec == 1 ? OFF_K : OFF_V)));
            float* dstf = nullptr;
            if (!latent && sec > 0) {
                if (EPI == EPI_QKV_DIFF) dstf = p.out + (sec == 1 ? OUT_NDK : OUT_NDV);
                else dstf = p.out + (sec == 1 ? OUT_NSK : OUT_NSV);
            }
#pragma unroll
            for (int mt = 0; mt < 4; ++mt) {
                u32x2 o[4];
#pragma unroll
                for (int nt = 0; nt < 4; ++nt) {
                    const size_t idx = (size_t)(mbase + mt * 16) * pitch + cofs + g * 4 + nt * 16;
                    const f32x4 v = acc[mt][nt];
                    const f32x4 vs = (sec == 0) ? v * SC : v;
                    o[nt][0] = pack2(vs[0], vs[1]); o[nt][1] = pack2(vs[2], vs[3]);
                    if (dstf) *(f32x4*)(dstf + idx) = v;
                }
                bf16_t* rowp = dstb + (size_t)(mbase + mt * 16) * pitch + cofs;
                store_pair16(rowp, o[0], o[1], g);
                store_pair16(rowp + 32, o[2], o[3], g);
            }
        }
    }
}

#undef GEMM_STAGE
template <bool DIFF>
__device__ void attn_phase(const Params& p, char* lds) {
    constexpr int DV = DIFF ? 128 : 64, MT = DV / 16;
    constexpr int KBYTES = DIFF ? 16384 : 8192, VPITCH = DV * 2 + 32, BUFB = KBYTES + 64 * VPITCH;
    constexpr int NCH = DIFF ? 2 : 1, KSTEP = DIFF ? 32 : 64, PITCH = DIFF ? 1024 : 256;
    static_assert(2 * BUFB <= LDS_MAIN, "lds");
    const int tid = threadIdx.x, lane = tid & 63, w = tid >> 6, sub = w & 1, qg = w >> 1, lr = lane & 15, g = lane >> 4;
    const bf16_t* qbuf = (const bf16_t*)(p.ws + OFF_Q);
    const bf16_t* kbuf = (const bf16_t*)(p.ws + OFF_K);
    const bf16_t* vbuf = (const bf16_t*)(p.ws + OFF_V);
    bf16_t* obuf = (bf16_t*)(p.ws + OFF_O);
    float lam = 0.f;
    if (DIFF) {
        const float* dl = p.diff_lambda;
        const float a = wave_sum(dl[lane] * dl[64 + lane]), b = wave_sum(dl[128 + lane] * dl[192 + lane]);
        lam = __expf(a) - __expf(b) + 0.2f;
    }
    const int skey = DIFF ? (tid >> 4) : (tid >> 3), sch = DIFF ? (tid & 15) : (tid & 7);
    const int k_st = DIFF ? ((sch >> 3) * 8192 + skey * 128 + (((sch & 7) ^ ((skey >> 1) & 7)) << 4)) : (skey * 128 + ((sch ^ ((skey >> 1) & 7)) << 4));
    const int v_st = KBYTES + skey * VPITCH + sch * 16;
    const int g_off = skey * PITCH + sch * 8;

    const bool bg_first = (__popc(blockIdx.x) & 1) != 0;
    if (DIFF && bg_first) deferred_transposes(p, lds);
    for (int u = blockIdx.x; u < 512; u += gridDim.x) {
        int qtok0, n0t, t_lo, t_hi, vhead, qpos0 = 0;
        bool band = false;
        const bf16_t *K0 = nullptr, *V0 = nullptr, *K1, *V1;
        float m_init = 0.f, l_init = 0.f;
        if (DIFF) {
            int b, h, qb;
            if (u < 256) {
                const int xcd = u & 7, slot = u >> 3, bh = xcd * 2 + (slot >> 4);
                qb = slot & 15; b = bh >> 3; h = bh & 7;
                qtok0 = NPROMPT + b * 2048 + qb * 128;
                K0 = (const bf16_t*)(p.ws + OFF_CKD) + (size_t)(b * 512) * 1024 + h * 128;
                V0 = (const bf16_t*)(p.ws + OFF_CVD) + (size_t)(b * 512) * 1024 + h * 128;
                n0t = 8;
                K1 = kbuf + (size_t)(NPROMPT + b * 2048) * 1024 + h * 128;
                V1 = vbuf + (size_t)(NPROMPT + b * 2048) * 1024 + h * 128;
                t_lo = 0; t_hi = 32;
            } else {
                const int v = u - 256;
                b = v >> 4; h = (v >> 1) & 7; qb = v & 1;
                qtok0 = b * 256 + qb * 128;
                n0t = 0;
                K1 = kbuf + (size_t)(b * 256) * 1024 + h * 128;
                V1 = vbuf + (size_t)(b * 256) * 1024 + h * 128;
                t_lo = 0; t_hi = 4;
            }
            vhead = h * 2 + sub;
        } else {
            int b, kv, hp, qb;
            if (u < 256) {
                const int xcd = u & 7, slot = u >> 3;
                b = xcd >> 2; kv = xcd & 3; hp = slot >> 4; qb = slot & 15;
                qtok0 = NPROMPT + b * 2048 + qb * 128;
                K0 = (const bf16_t*)(p.ws + OFF_CKS) + (size_t)(b * 512) * 256 + kv * 64;
                V0 = (const bf16_t*)(p.ws + OFF_CVS) + (size_t)(b * 512) * 256 + kv * 64;
                n0t = 8;
                K1 = kbuf + (size_t)(NPROMPT + b * 2048) * 256 + kv * 64;
                V1 = vbuf + (size_t)(NPROMPT + b * 2048) * 256 + kv * 64;
                t_lo = 2 * qb - 2 < 0 ? 0 : 2 * qb - 2; t_hi = 2 * qb + 4 > 32 ? 32 : 2 * qb + 4;
                band = true; qpos0 = qb * 128;
            } else {
                const int v = u - 256;
                b = v >> 4; kv = (v >> 2) & 3; hp = (v >> 1) & 1; qb = v & 1;
                qtok0 = b * 256 + qb * 128;
                n0t = 0;
                K1 = kbuf + (size_t)(b * 256) * 256 + kv * 64;
                V1 = vbuf + (size_t)(b * 256) * 256 + kv * 64;
                t_lo = 0; t_hi = 4;
            }
            vhead = kv * 4 + hp * 2 + sub;
            m_init = p.swa_sink[vhead] * LOG2E;
            l_init = (g == 0) ? 1.f : 0.f;
        }
        const int ntile = n0t + (t_hi - t_lo);
        bf16x8 qf[2][2];
#pragma unroll
        for (int nt = 0; nt < 2; ++nt)
#pragma unroll
            for (int ks = 0; ks < 2; ++ks)
                qf[nt][ks] = *(const bf16x8*)(qbuf + (size_t)(qtok0 + qg * 32 + nt * 16 + lr) * 1024 + vhead * 64 + ks * 32 + g * 8);
        f32x4 O[MT][2];
#pragma unroll
        for (int i = 0; i < MT; ++i) { O[i][0] = (f32x4){0.f, 0.f, 0.f, 0.f}; O[i][1] = (f32x4){0.f, 0.f, 0.f, 0.f}; }
        float mrun[2] = {m_init, m_init}, lrun[2] = {l_init, l_init};

        u32x4 rk[NCH], rv[NCH];
        {
            const bf16_t* kp = (n0t > 0) ? K0 : K1 + (size_t)t_lo * 64 * PITCH;
            const bf16_t* vp = (n0t > 0) ? V0 : V1 + (size_t)t_lo * 64 * PITCH;
#pragma unroll
            for (int c = 0; c < NCH; ++c) { rk[c] = *(const u32x4*)(kp + g_off + c * KSTEP * PITCH); rv[c] = *(const u32x4*)(vp + g_off + c * KSTEP * PITCH); }
#pragma unroll
            for (int c = 0; c < NCH; ++c) { *(u32x4*)(lds + k_st + c * KSTEP * 128) = rk[c]; *(u32x4*)(lds + v_st + c * KSTEP * VPITCH) = rv[c]; }
        }
        __syncthreads();
        for (int i = 0; i < ntile; ++i) {
            const bool more = i + 1 < ntile;
            if (more) {
                const int j = i + 1;
                const bf16_t* kp = (j < n0t) ? K0 + (size_t)j * 64 * PITCH : K1 + (size_t)(t_lo + j - n0t) * 64 * PITCH;
                const bf16_t* vp = (j < n0t) ? V0 + (size_t)j * 64 * PITCH : V1 + (size_t)(t_lo + j - n0t) * 64 * PITCH;
#pragma unroll
                for (int c = 0; c < NCH; ++c) { rk[c] = *(const u32x4*)(kp + g_off + c * KSTEP * PITCH); rv[c] = *(const u32x4*)(vp + g_off + c * KSTEP * PITCH); }
            }
            __builtin_amdgcn_sched_barrier(0);
            const char* buf = lds + (i & 1) * BUFB;
            const char* kb = buf + (DIFF ? sub * 8192 : 0);
            const char* vb = buf + KBYTES;
            f32x4 S[4][2];
            const f32x4 cin0 = {-mrun[0], -mrun[0], -mrun[0], -mrun[0]}, cin1 = {-mrun[1], -mrun[1], -mrun[1], -mrun[1]};
#pragma unroll
            for (int kt = 0; kt < 4; ++kt) {
                const bf16x8 kf = *(const bf16x8*)(kb + (kt * 16 + lr) * 128 + ((g ^ (lr >> 1)) << 4));
                S[kt][0] = MFMA16(kf, qf[0][0], cin0);
                S[kt][1] = MFMA16(kf, qf[1][0], cin1);
            }
#pragma unroll
            for (int kt = 0; kt < 4; ++kt) {
                const bf16x8 kf = *(const bf16x8*)(kb + (kt * 16 + lr) * 128 + (((4 + g) ^ (lr >> 1)) << 4));
                S[kt][0] = MFMA16(kf, qf[0][1], S[kt][0]);
                S[kt][1] = MFMA16(kf, qf[1][1], S[kt][1]);
            }
            const bool domask = band && i >= n0t && (unsigned)((t_lo + i - n0t) - (qpos0 >> 6)) >= 2u;
            const int kpos0 = (t_lo + i - n0t) * 64 + g * 4;
#pragma unroll
            for (int nt = 0; nt < 2; ++nt) {
                const int qpos = qpos0 + qg * 32 + nt * 16 + lr;
                float mx = -3.0e38f;
                if (domask) {
#pragma unroll
                    for (int kt = 0; kt < 4; ++kt)
#pragma unroll
                        for (int r = 0; r < 4; ++r) { const int dlt = qpos - (kpos0 + kt * 16 + r); if (dlt > 128 || dlt < -128) S[kt][nt][r] = -1e30f; }
                }
#pragma unroll
                for (int kt = 0; kt < 4; ++kt)
#pragma unroll
                    for (int r = 0; r < 4; ++r) mx = fmaxf(mx, S[kt][nt][r]);
                if (__builtin_amdgcn_ballot_w64((mx > 8.f) || (DIFF && i == 0)) != 0ull) {
                    mx = rows_max(mx);
                    const bool raise = (mx > 8.f) || (DIFF && i == 0);
                    const float delta = raise ? fmaxf(mx, -100.f) : 0.f;
                    const float alpha = __builtin_amdgcn_exp2f(-delta);
                    mrun[nt] += delta;
                    lrun[nt] *= alpha;
#pragma unroll
                    for (int mt = 0; mt < MT; ++mt) O[mt][nt] = O[mt][nt] * alpha;
#pragma unroll
                    for (int kt = 0; kt < 4; ++kt) S[kt][nt] = S[kt][nt] - delta;
                }
                float ls = 0.f;
#pragma unroll
                for (int kt = 0; kt < 4; ++kt)
#pragma unroll
                    for (int r = 0; r < 4; ++r) {
                        const float pv = __builtin_amdgcn_exp2f(S[kt][nt][r]);
                        S[kt][nt][r] = pv;
                        ls += pv;
                    }
                lrun[nt] += ls;
            }
#pragma unroll
            for (int ks2 = 0; ks2 < 2; ++ks2) {
                bf16x8 pf[2];
#pragma unroll
                for (int nt = 0; nt < 2; ++nt) {
                    u32x4 pk;
                    pk[0] = pack2(S[2 * ks2][nt][0], S[2 * ks2][nt][1]); pk[1] = pack2(S[2 * ks2][nt][2], S[2 * ks2][nt][3]);
                    pk[2] = pack2(S[2 * ks2 + 1][nt][0], S[2 * ks2 + 1][nt][1]); pk[3] = pack2(S[2 * ks2 + 1][nt][2], S[2 * ks2 + 1][nt][3]);
                    pf[nt] = __builtin_bit_cast(bf16x8, pk);
                }
                const char* vrow = vb + (ks2 * 32 + g * 4 + (lr >> 2)) * VPITCH + (lr & 3) * 8;
#pragma unroll
                for (int mt = 0; mt < MT; ++mt) {
                    const s16x4 v0 = __builtin_amdgcn_ds_read_tr16_b64_v4i16((s16x4 __attribute__((address_space(3)))*)(vrow + mt * 32));
                    const s16x4 v1 = __builtin_amdgcn_ds_read_tr16_b64_v4i16((s16x4 __attribute__((address_space(3)))*)(vrow + mt * 32 + 16 * VPITCH));
                    const bf16x8 vf = __builtin_shufflevector(v0, v1, 0, 1, 2, 3, 4, 5, 6, 7);
                    O[mt][0] = MFMA16(vf, pf[0], O[mt][0]);
                    O[mt][1] = MFMA16(vf, pf[1], O[mt][1]);
                }
            }
            if (more) {
                char* nb = lds + ((i + 1) & 1) * BUFB;
#pragma unroll
                for (int c = 0; c < NCH; ++c) { *(u32x4*)(nb + k_st + c * KSTEP * 128) = rk[c]; *(u32x4*)(nb + v_st + c * KSTEP * VPITCH) = rv[c]; }
            }
            __syncthreads();
        }
#pragma unroll
        for (int nt = 0; nt < 2; ++nt) {
            const float l = rows_sum(lrun[nt]);
            const float inv = __builtin_amdgcn_rcpf(l);
#pragma unroll
            for (int mt = 0; mt < MT; ++mt) O[mt][nt] = O[mt][nt] * inv;
        }
        if (DIFF) {
            float* ex = (float*)lds;
            if (sub == 1) {
#pragma unroll
                for (int nt = 0; nt < 2; ++nt)
#pragma unroll
                    for (int mt = 0; mt < MT; ++mt)
#pragma unroll
                        for (int r = 0; r < 4; ++r) ex[((qg * 2 + nt) * 32 + mt * 4 + r) * 64 + lane] = O[mt][nt][r];
            }
            __syncthreads();
            if (sub == 0) {
                const float* gs = p.diff_subln_g;
                const int h = vhead >> 1;
#pragma unroll
                for (int nt = 0; nt < 2; ++nt) {
                    float ss = 0.f;
#pragma unroll
                    for (int mt = 0; mt < MT; ++mt)
#pragma unroll
                        for (int r = 0; r < 4; ++r) {
                            const float d = O[mt][nt][r] - lam * ex[((qg * 2 + nt) * 32 + mt * 4 + r) * 64 + lane];
                            O[mt][nt][r] = d;
                            ss += d * d;
                        }
                    ss = rows_sum(ss);
                    const float rstd = rsqrtf(ss * (1.f / 128.f) + EPS) * 0.8f;
                    bf16_t* orow = obuf + (size_t)(qtok0 + qg * 32 + nt * 16 + lr) * 1024 + h * 128;
#pragma unroll
                    for (int mp = 0; mp < MT / 2; ++mp) {
                        u32x2 o[2];
#pragma unroll
                        for (int e = 0; e < 2; ++e) {
                            const int mt = 2 * mp + e;
                            const f32x4 gg = *(const f32x4*)(gs + mt * 16 + g * 4);
                            const f32x4 v = O[mt][nt] * rstd * gg;
                            o[e][0] = pack2(v[0], v[1]); o[e][1] = pack2(v[2], v[3]);
                        }
                        store_pair16(orow + mp * 32, o[0], o[1], g);
                    }
                }
            }
            __syncthreads();
        } else {
#pragma unroll
            for (int nt = 0; nt < 2; ++nt) {
                bf16_t* orow = obuf + (size_t)(qtok0 + qg * 32 + nt * 16 + lr) * 1024 + vhead * 64;
#pragma unroll
                for (int mp = 0; mp < MT / 2; ++mp) {
                    const f32x4 v0 = O[2 * mp][nt], v1 = O[2 * mp + 1][nt];
                    u32x2 a, b; a[0] = pack2(v0[0], v0[1]); a[1] = pack2(v0[2], v0[3]); b[0] = pack2(v1[0], v1[1]); b[1] = pack2(v1[2], v1[3]);
                    store_pair16(orow + mp * 32, a, b, g);
                }
            }
        }
    }
    if (DIFF && !bg_first) deferred_transposes(p, lds);
}

__global__ void __launch_bounds__(512, 2) mega(Params p) {
    extern __shared__ __attribute__((aligned(16))) char lds[];
    cg::grid_group grid = cg::this_grid();
    if (p.ws == nullptr) grid.sync();
    volatile LAS unsigned* st = (volatile LAS unsigned*)(lds + LDS_MAIN);
    if (threadIdx.x == 0) { st[0] = 0u; st[1] = 0u; st[2] = 0u; st[3] = 0u; }
    __syncthreads();
    const XcdBarrier xb = xcd_barrier_post((unsigned*)(p.ws + OFF_BAR), st);
    const bf16_t* hbuf = (const bf16_t*)(p.ws + OFF_H);
    const bf16_t* obuf = (const bf16_t*)(p.ws + OFF_O);
    const bf16_t* ubuf = (const bf16_t*)(p.ws + OFF_U);
    prepass(p, lds);
    xcd_barrier(xb);
    rowphase<0>(p, 0);
    xcd_barrier(xb);
    gemm_phase<EPI_QKV_DIFF>(p, hbuf, (const bf16_t*)(p.ws + OFF_WQKV0), 3072, 1024, lds);
    xcd_barrier(xb);
    attn_phase<true>(p, lds);
    xcd_barrier(xb);
    gemm_phase<EPI_F32>(p, obuf, (const bf16_t*)(p.ws + OFF_WO0), 1024, 1024, lds);
    xcd_barrier(xb);
    rowphase<1>(p, 0);
    xcd_barrier(xb);
    gemm_phase<EPI_GU>(p, hbuf, (const bf16_t*)(p.ws + OFF_WGU0), 5632, 1024, lds);
    xcd_barrier(xb);
    gemm_phase<EPI_F32>(p, ubuf, (const bf16_t*)(p.ws + OFF_WD0), 1024, 2816, lds);
    xcd_barrier(xb);
    rowphase<2>(p, 0);
    xcd_barrier(xb);
    gemm_phase<EPI_QKV_SWA>(p, hbuf, (const bf16_t*)(p.ws + OFF_WQKV1), 1536, 1024, lds);
    xcd_barrier(xb);
    attn_phase<false>(p, lds);
    xcd_barrier(xb);
    gemm_phase<EPI_F32>(p, obuf, (const bf16_t*)(p.ws + OFF_WO1), 1024, 1024, lds);
    xcd_barrier(xb);
    rowphase<1>(p, 1);
    xcd_barrier(xb);
    gemm_phase<EPI_GU>(p, hbuf, (const bf16_t*)(p.ws + OFF_WGU1), 5632, 1024, lds);
    xcd_barrier(xb);
    gemm_phase<EPI_F32>(p, ubuf, (const bf16_t*)(p.ws + OFF_WD1), 1024, 2816, lds);
    xcd_barrier(xb);
    rowphase<2>(p, 1);
}

extern "C" void kernel_launch(void* const* d_in, const int* in_sizes, int n_in, void* d_out, int out_size, void* d_ws, size_t ws_size, hipStream_t stream) {
    static int grid_blocks = 0;
    if (grid_blocks == 0) {
        if (n_in != 21 || ws_size < WS_END) { fprintf(stderr, "kernel_launch: unexpected inputs (n_in %d, ws %zu < %zu)\n", n_in, ws_size, (size_t)WS_END); grid_blocks = -1; return; }
        int dev = 0, cus = 0, per_cu = 0;
        (void)hipGetDevice(&dev);
        (void)hipDeviceGetAttribute(&cus, hipDeviceAttributeMultiprocessorCount, dev);
        if (hipFuncSetAttribute((const void*)mega, hipFuncAttributeMaxDynamicSharedMemorySize, LDS_BYTES) != hipSuccess) { fprintf(stderr, "kernel_launch: hipFuncSetAttribute failed\n"); grid_blocks = -1; return; }
        if (hipOccupancyMaxActiveBlocksPerMultiprocessor(&per_cu, (const void*)mega, NTHR, LDS_BYTES) != hipSuccess || per_cu < 1) { fprintf(stderr, "kernel_launch: occupancy query failed (%d)\n", per_cu); grid_blocks = -1; return; }
        if (per_cu > 1) per_cu = 1;
        grid_blocks = cus * per_cu;
        fprintf(stderr, "kernel_launch: %d CUs x %d = %d workgroups\n", cus, per_cu, grid_blocks);
    }
    if (grid_blocks < 0) return;
    if (hipMemsetAsync((char*)d_ws + OFF_BAR, 0, XCD_BAR_WORDS * 4, stream) != hipSuccess) { fprintf(stderr, "kernel_launch: memset failed\n"); return; }
    Params p{};
    const float** pp = (const float**)&p;
    for (int i = 0; i < 21; ++i) pp[i] = (const float*)d_in[i];
    p.out = (float*)d_out;
    p.ws = (char*)d_ws;
    void* args[] = {&p};
    hipError_t e = hipLaunchCooperativeKernel((const void*)mega, dim3(grid_blocks), dim3(NTHR), args, LDS_BYTES, stream);
    if (e != hipSuccess) fprintf(stderr, "cooperative launch failed: %s (grid %d)\n", hipGetErrorString(e), grid_blocks);
}
```

```cpp
#include <hip/hip_runtime.h>
#include <hip/hip_cooperative_groups.h>
#include <cstdint>
#include <cstdio>
namespace cg = cooperative_groups;

typedef unsigned short bf16_t;
typedef short bf16x8 __attribute__((ext_vector_type(8)));
typedef short s16x4 __attribute__((ext_vector_type(4)));
typedef float f32x4 __attribute__((ext_vector_type(4)));
typedef float f32x2 __attribute__((ext_vector_type(2)));
typedef unsigned u32x4 __attribute__((ext_vector_type(4)));
typedef unsigned u32x2 __attribute__((ext_vector_type(2)));
typedef __bf16 bf2_t __attribute__((ext_vector_type(2)));
#define DI __device__ __forceinline__
#define MFMA16(a, b, c) __builtin_amdgcn_mfma_f32_16x16x32_bf16((a), (b), (c), 0, 0, 0)

constexpr int D = 1024, NTOK = 8192, NPROMPT = 4096, DFF = 2816;
constexpr float EPS = 1e-6f, LOG2E = 1.4426950408889634f, SC = 0.125f * 1.4426950408889634f;

constexpr size_t OFF_MOD = 0;
constexpr size_t OFF_ROPE = 147456;
constexpr size_t OFF_BAR = 163840;
constexpr size_t OFF_WQKV0 = 1u << 20;
constexpr size_t OFF_WO0 = OFF_WQKV0 + 3072ull * 1024 * 2;
constexpr size_t OFF_WGU0 = OFF_WO0 + 1024ull * 1024 * 2;
constexpr size_t OFF_WD0 = OFF_WGU0 + 5632ull * 1024 * 2;
constexpr size_t OFF_WQKV1 = OFF_WD0 + 1024ull * 2816 * 2;
constexpr size_t OFF_WO1 = OFF_WQKV1 + 1536ull * 1024 * 2;
constexpr size_t OFF_WGU1 = OFF_WO1 + 1024ull * 1024 * 2;
constexpr size_t OFF_WD1 = OFF_WGU1 + 5632ull * 1024 * 2;
constexpr size_t OFF_CKD = OFF_WD1 + 1024ull * 2816 * 2;
constexpr size_t OFF_CVD = OFF_CKD + 1024ull * 1024 * 2;
constexpr size_t OFF_CKS = OFF_CVD + 1024ull * 1024 * 2;
constexpr size_t OFF_CVS = OFF_CKS + 1024ull * 256 * 2;
constexpr size_t OFF_H = OFF_CVS + 1024ull * 256 * 2;
constexpr size_t OFF_Q = OFF_H + 8192ull * 1024 * 2;
constexpr size_t OFF_K = OFF_Q + 8192ull * 1024 * 2;
constexpr size_t OFF_V = OFF_K + 8192ull * 1024 * 2;
constexpr size_t OFF_U = OFF_Q;
constexpr size_t OFF_O = OFF_V + 8192ull * 1024 * 2;
constexpr size_t OFF_Y = OFF_O + 8192ull * 1024 * 2;
constexpr size_t OFF_X = OFF_Y + 8192ull * 1024 * 4;
constexpr size_t WS_END = OFF_X + 8192ull * 1024 * 4;
static_assert(8192ull * 2816 * 2 <= 3 * 8192ull * 1024 * 2, "U overlay");

constexpr size_t OUT_Y = 0, OUT_NDK = 8388608, OUT_NDV = 12582912, OUT_NSK = 16777216, OUT_NSV = 17825792;

constexpr int NTHR = 512, NWAVE = 8;
constexpr int LDS_MAIN = 147456, LDS_BYTES = LDS_MAIN + 16;

struct Params {
    const float *x_prompt, *x_sample, *cdk, *cdv, *csk, *csv, *c, *c_ctx, *w_mod, *b_mod, *norm_g, *w_qkv_diff, *diff_lambda, *diff_subln_g,
        *w_o_diff, *w_qkv_swa, *swa_sink, *w_o_swa, *w_gate, *w_up, *w_down;
    float* out;
    char* ws;
};

DI unsigned pack2(float a, float b) { bf2_t v; v[0] = (__bf16)a; v[1] = (__bf16)b; return __builtin_bit_cast(unsigned, v); }
DI float wave_sum(float v) {
#pragma unroll
    for (int o = 32; o > 0; o >>= 1) v += __shfl_xor(v, o);
    return v;
}
DI float rows_max(float v) {
    auto a = __builtin_amdgcn_permlane16_swap(__float_as_uint(v), __float_as_uint(v), false, false);
    v = fmaxf(__uint_as_float(a[0]), __uint_as_float(a[1]));
    auto b = __builtin_amdgcn_permlane32_swap(__float_as_uint(v), __float_as_uint(v), false, false);
    return fmaxf(__uint_as_float(b[0]), __uint_as_float(b[1]));
}
DI float rows_sum(float v) {
    auto a = __builtin_amdgcn_permlane16_swap(__float_as_uint(v), __float_as_uint(v), false, false);
    v = __uint_as_float(a[0]) + __uint_as_float(a[1]);
    auto b = __builtin_amdgcn_permlane32_swap(__float_as_uint(v), __float_as_uint(v), false, false);
    return __uint_as_float(b[0]) + __uint_as_float(b[1]);
}
DI float silu_f(float x) { return x * __builtin_amdgcn_rcpf(1.f + __expf(-x)); }


#define XB_TMO      128
#define XB_XCNT(j)  (256  + 64 * (j))
#define XB_XSUB(j)  (1280 + 64 * (j))
#define XB_XGEN(j)  (2304 + 64 * (j))
#define XB_TOP      3328
#define XB_TOPGEN   3392
#define XCD_BAR_WORDS 3456
#define XB_SPIN_CAP (1u << 18)
#define LAS __attribute__((address_space(3)))
DI unsigned xb_ld(unsigned* p) { return __hip_atomic_load(p, __ATOMIC_RELAXED, __HIP_MEMORY_SCOPE_AGENT); }
DI unsigned xb_add(unsigned* p, unsigned v) { return __hip_atomic_fetch_add(p, v, __ATOMIC_RELAXED, __HIP_MEMORY_SCOPE_AGENT); }
DI unsigned xb_xcc_id() { return (unsigned)__builtin_amdgcn_s_getreg((3 << 11) | 20) & 0xFu; }
#define XB_SPIN(cond, bar) do { unsigned _sp = 0; while (cond) { __builtin_amdgcn_s_sleep(1); \
    if ((++_sp & 255u) == 0u) { if (xb_ld(&(bar)[XB_TMO])) break; if (_sp > XB_SPIN_CAP) { atomicAdd(&(bar)[XB_TMO], 1u); break; } } } } while (0)
struct XcdBarrier { unsigned* bar; unsigned x; volatile LAS unsigned* st; };
DI XcdBarrier xcd_barrier_post(unsigned* bar, volatile LAS unsigned* st) {
    XcdBarrier b; b.bar = bar; b.x = xb_xcc_id(); b.st = st;
    if (threadIdx.x == 0) (void)xb_add(&bar[XB_XCNT(b.x)], 1u);
    return b;
}
DI void xcd_barrier_complete(unsigned* bar, unsigned x, unsigned& nloc, unsigned& nx) {
    const unsigned G = gridDim.x * gridDim.y * gridDim.z;
    unsigned sum, cnt, mine, sp = 0u;
    for (;;) {
        sum = 0u; cnt = 0u; mine = 0u;
#pragma unroll
        for (unsigned j = 0; j < 16; ++j) { const unsigned c = xb_ld(&bar[XB_XCNT(j)]); sum += c; cnt += (c > 0u) ? 1u : 0u; mine = (j == x) ? c : mine; }
        if (sum == G) break;
        __builtin_amdgcn_s_sleep(1);
        if ((++sp & 255u) == 0u) { if (xb_ld(&bar[XB_TMO])) break; if (sp > XB_SPIN_CAP) { atomicAdd(&bar[XB_TMO], 1u); break; } }
    }
    nloc = mine > 0u ? mine : 1u; nx = cnt > 0u ? cnt : 1u;
}
DI void xcd_barrier(const XcdBarrier& b) {
    asm volatile("s_waitcnt vmcnt(0)" ::: "memory");
    __syncthreads();
    if (threadIdx.x == 0) {
        unsigned* bar = b.bar;
        __builtin_amdgcn_s_waitcnt(0);
        unsigned nloc = b.st[0], nx = b.st[1];
        if (nloc == 0u) { xcd_barrier_complete(bar, b.x, nloc, nx); b.st[0] = nloc; b.st[1] = nx; }
        const unsigned old = xb_add(&bar[XB_XSUB(b.x)], 1u);
        const unsigned gen = old / nloc;
        if (old + 1u == (gen + 1u) * nloc) {
            __builtin_amdgcn_fence(__ATOMIC_RELEASE, "agent");
            asm volatile("s_waitcnt vmcnt(0)" ::: "memory");
            const unsigned og = xb_add(&bar[XB_TOP], 1u);
            const unsigned tg = og / nx;
            if (og + 1u == (tg + 1u) * nx) xb_add(&bar[XB_TOPGEN], 1u);
            else XB_SPIN(xb_ld(&bar[XB_TOPGEN]) == tg, bar);
            __builtin_amdgcn_fence(__ATOMIC_ACQUIRE, "agent");
            xb_add(&bar[XB_XGEN(b.x)], 1u);
            asm volatile("s_waitcnt vmcnt(0)" ::: "memory");
        } else {
            XB_SPIN(xb_ld(&bar[XB_XGEN(b.x)]) == gen, bar);
            __builtin_amdgcn_fence(__ATOMIC_ACQUIRE, "agent");
            asm volatile("s_waitcnt vmcnt(0)" ::: "memory");
        }
    }
    __syncthreads();
}

DI void transpose_item_wave(const float* __restrict__ src, int ld, int k0, int c0, bf16_t* __restrict__ dst, int K, int nrow0, float* scr, int lane) {
#pragma unroll 8
    for (int i = 0; i < 32; ++i) { const int kk = 2 * i + (lane >> 5); scr[kk * 33 + (lane & 31)] = src[(size_t)(k0 + kk) * ld + c0 + (lane & 31)]; }
    asm volatile("s_waitcnt lgkmcnt(0)" ::: "memory");
    const int c = lane & 7;
#pragma unroll
    for (int j = 0; j < 4; ++j) {
        const int n = (lane >> 3) + 8 * j;
        const float* r = scr + (8 * c) * 33 + n;
        u32x4 o;
        o[0] = pack2(r[0 * 33], r[1 * 33]); o[1] = pack2(r[2 * 33], r[3 * 33]); o[2] = pack2(r[4 * 33], r[5 * 33]); o[3] = pack2(r[6 * 33], r[7 * 33]);
        *(u32x4*)(dst + (size_t)(nrow0 + n) * K + k0 + 8 * c) = o;
    }
    asm volatile("s_waitcnt lgkmcnt(0)" ::: "memory");
}

DI void tr_block_item(const Params& p, int bi, char* lds) {
    const int tid = threadIdx.x;
    int ti = bi * NWAVE + (tid >> 6);
    const int l = ti >= 6272 ? 1 : 0; ti -= l * 6272;
    const int nq = l ? 1536 : 3072, i_qkv = 16 * (nq / 32);
    const float* src; const float* src2 = nullptr; int ld, K; bf16_t* dst; bool gu = false;
    if (ti < i_qkv) { src = l ? p.w_qkv_swa : p.w_qkv_diff; ld = nq; K = 1024; dst = (bf16_t*)(p.ws + (l ? OFF_WQKV1 : OFF_WQKV0)); }
    else if ((ti -= i_qkv) < 512) { src = l ? p.w_o_swa : p.w_o_diff; ld = 1024; K = 1024; dst = (bf16_t*)(p.ws + (l ? OFF_WO1 : OFF_WO0)); }
    else if ((ti -= 512) < 2816) { src = p.w_gate + (size_t)l * 1024 * 2816; src2 = p.w_up + (size_t)l * 1024 * 2816; ld = 2816; K = 1024; dst = (bf16_t*)(p.ws + (l ? OFF_WGU1 : OFF_WGU0)); gu = true; }
    else { ti -= 2816; src = p.w_down + (size_t)l * 2816 * 1024; ld = 1024; K = 2816; dst = (bf16_t*)(p.ws + (l ? OFF_WD1 : OFF_WD0)); }
    const int nkb = K / 64, kb = ti % nkb, nb = ti / nkb;
    int c0 = nb * 32;
    if (gu) { const int tile = nb >> 2, wc = (nb >> 1) & 1, isup = nb & 1; c0 = tile * 64 + wc * 32; if (isup) src = src2; }
    transpose_item_wave(src, ld, kb * 64, c0, dst, K, nb * 32, (float*)lds + (tid >> 6) * (64 * 33), tid & 63);
}
constexpr int TR_P0 = 192, TR_ALL = 1472;
__device__ void deferred_transposes(const Params& p, char* lds) {
    __syncthreads();
    for (int bi = TR_P0 + blockIdx.x; bi < TR_ALL; bi += gridDim.x) tr_block_item(p, bi, lds);
    __syncthreads();
}

__device__ void prepass(const Params& p, char* lds) {
    const int tid = threadIdx.x;
    constexpr int N_MOD = 192, N_ROPE = 2, N_TR = TR_P0, N_CACHE = 640;
    constexpr int TOTAL = N_MOD + N_ROPE + N_TR + N_CACHE;
    for (int it = blockIdx.x; it < TOTAL; it += gridDim.x) {
        if (it < N_MOD) {
            const int l = it / 96, n0 = (it % 96) * 64;
            float* sc = (float*)lds;
            float* red = sc + 3 * 1024;
            for (int e = tid; e < 3 * 1024; e += NTHR) {
                const int c = e >> 10, k = e & 1023;
                const float v = (c == 0) ? p.c_ctx[k] : p.c[(c - 1) * 1024 + k];
                sc[e] = silu_f(v);
            }
            __syncthreads();
            const int c4 = tid & 15, kg = tid >> 4;
            const float* w = p.w_mod + (size_t)l * 1024 * 6144 + (size_t)(kg * 32) * 6144 + n0 + c4 * 4;
            f32x4 a0 = {0.f, 0.f, 0.f, 0.f}, a1 = a0, a2 = a0;
#pragma unroll 8
            for (int k = 0; k < 32; ++k) {
                const f32x4 wv = *(const f32x4*)(w + (size_t)k * 6144);
                a0 += wv * sc[kg * 32 + k]; a1 += wv * sc[1024 + kg * 32 + k]; a2 += wv * sc[2048 + kg * 32 + k];
            }
            *(f32x4*)(red + (kg * 3 + 0) * 64 + c4 * 4) = a0; *(f32x4*)(red + (kg * 3 + 1) * 64 + c4 * 4) = a1; *(f32x4*)(red + (kg * 3 + 2) * 64 + c4 * 4) = a2;
            __syncthreads();
            if (tid < 192) {
                const int c = tid >> 6, cc = tid & 63;
                float s = p.b_mod[l * 6144 + n0 + cc];
#pragma unroll
                for (int q = 0; q < 32; ++q) s += red[(q * 3 + c) * 64 + cc];
                ((float*)(p.ws + OFF_MOD))[(l * 3 + c) * 6144 + n0 + cc] = s;
            }
            __syncthreads();
        } else if (it < N_MOD + N_ROPE) {
            float* rt = (float*)(p.ws + OFF_ROPE);
            const int e = (it - N_MOD) * NTHR + tid;
            const int pos = e >> 4, i = e & 15;
            const float inv = (float)exp2(-((double)i / 16.0) * 13.287712379549449);
            const float ang = (float)pos * inv;
            rt[e * 2] = (float)cos((double)ang);
            rt[e * 2 + 1] = (float)sin((double)ang);
        } else if (it < N_MOD + N_ROPE + N_TR) {
            tr_block_item(p, it - (N_MOD + N_ROPE), lds);
        } else {
            int ci = it - (N_MOD + N_ROPE + N_TR);
            const float* src; bf16_t* dst;
            if (ci < 256) { src = p.cdk; dst = (bf16_t*)(p.ws + OFF_CKD); }
            else if (ci < 512) { src = p.cdv; dst = (bf16_t*)(p.ws + OFF_CVD); ci -= 256; }
            else if (ci < 576) { src = p.csk; dst = (bf16_t*)(p.ws + OFF_CKS); ci -= 512; }
            else { src = p.csv; dst = (bf16_t*)(p.ws + OFF_CVS); ci -= 576; }
            const size_t e = (size_t)ci * 4096 + tid * 8;
            const f32x4 a = *(const f32x4*)(src + e), b = *(const f32x4*)(src + e + 4);
            u32x4 o; o[0] = pack2(a[0], a[1]); o[1] = pack2(a[2], a[3]); o[2] = pack2(b[0], b[1]); o[3] = pack2(b[2], b[3]);
            *(u32x4*)(dst + e) = o;
        }
    }
}

DI void bf8_to_f32(const u32x4 r, f32x4& a, f32x4& b) {
    a = (f32x4){__uint_as_float(r[0] << 16), __uint_as_float(r[0] & 0xffff0000u), __uint_as_float(r[1] << 16), __uint_as_float(r[1] & 0xffff0000u)};
    b = (f32x4){__uint_as_float(r[2] << 16), __uint_as_float(r[2] & 0xffff0000u), __uint_as_float(r[3] << 16), __uint_as_float(r[3] & 0xffff0000u)};
}
DI u32x4 f32_to_bf8(const f32x4 a, const f32x4 b) { u32x4 o; o[0] = pack2(a[0], a[1]); o[1] = pack2(a[2], a[3]); o[2] = pack2(b[0], b[1]); o[3] = pack2(b[2], b[3]); return o; }

template <int MODE>
__device__ void rowphase(const Params& p, int layer) {
    const int lane = threadIdx.x & 63, w = threadIdx.x >> 6;
    const float* mod = (const float*)(p.ws + OFF_MOD);
    bf16_t* xbuf = (bf16_t*)(p.ws + OFF_X);
    const bf16_t* ybuf = (const bf16_t*)(p.ws + OFF_Y);
    bf16_t* hbuf = (bf16_t*)(p.ws + OFF_H);
    constexpr int RB = 4;
    const bool last = (MODE == 2 && layer == 1);
    for (int rb = blockIdx.x * NWAVE + w; rb < NTOK / RB; rb += gridDim.x * NWAVE) {
        const int rowb = rb * RB;
        const int cond = rowb < NPROMPT ? 0 : 1 + ((rowb - NPROMPT) >> 11);
        const float* mrow = mod + (size_t)(layer * 3 + cond) * 6144;
        const int nl = (MODE == 2) ? layer + 1 : layer;
        const float* mrow2 = mod + (size_t)(nl * 3 + cond) * 6144;
        f32x4 vgpost[4], vgate[4], vgpre[4], vshift[4], vscale[4];
#pragma unroll
        for (int q = 0; q < 4; ++q) {
            const int o = (q >> 1) * 512 + lane * 8 + (q & 1) * 4;
            if (MODE != 0) {
                vgpost[q] = *(const f32x4*)(p.norm_g + (size_t)(layer * 4 + (MODE == 1 ? 1 : 3)) * D + o);
                vgate[q] = *(const f32x4*)(mrow + (MODE == 1 ? 2 : 5) * D + o);
            }
            if (!last) {
                vgpre[q] = *(const f32x4*)(p.norm_g + (size_t)(nl * 4 + (MODE == 1 ? 2 : 0)) * D + o);
                vshift[q] = *(const f32x4*)(mrow2 + (MODE == 1 ? 3 : 0) * D + o);
                vscale[q] = *(const f32x4*)(mrow2 + (MODE == 1 ? 4 : 1) * D + o) + 1.f;
            }
        }
#pragma unroll 2
        for (int j = 0; j < RB; ++j) {
            const int row = rowb + j;
            f32x4 x[4];
            if (MODE == 2 || layer == 1) {
#pragma unroll
                for (int i = 0; i < 2; ++i) bf8_to_f32(*(const u32x4*)(xbuf + (size_t)row * D + i * 512 + lane * 8), x[2 * i], x[2 * i + 1]);
            } else {
                const float* xin = row < NPROMPT ? p.x_prompt + (size_t)row * D : p.x_sample + (size_t)(row - NPROMPT) * D;
#pragma unroll
                for (int q = 0; q < 4; ++q) x[q] = *(const f32x4*)(xin + (q >> 1) * 512 + lane * 8 + (q & 1) * 4);
            }
            if (MODE != 0) {
                f32x4 y[4];
                float ss = 0.f;
#pragma unroll
                for (int i = 0; i < 2; ++i) bf8_to_f32(*(const u32x4*)(ybuf + (size_t)row * D + i * 512 + lane * 8), y[2 * i], y[2 * i + 1]);
#pragma unroll
                for (int q = 0; q < 4; ++q) ss += y[q][0] * y[q][0] + y[q][1] * y[q][1] + y[q][2] * y[q][2] + y[q][3] * y[q][3];
                ss = wave_sum(ss);
                const float rstd = rsqrtf(ss * (1.f / D) + EPS);
#pragma unroll
                for (int q = 0; q < 4; ++q) x[q] = x[q] + vgate[q] * (y[q] * rstd * vgpost[q]);
#pragma unroll
                for (int i = 0; i < 2; ++i) {
                    if (last) {
                        *(f32x4*)(p.out + OUT_Y + (size_t)row * D + i * 512 + lane * 8) = x[2 * i];
                        *(f32x4*)(p.out + OUT_Y + (size_t)row * D + i * 512 + lane * 8 + 4) = x[2 * i + 1];
                    } else *(u32x4*)(xbuf + (size_t)row * D + i * 512 + lane * 8) = f32_to_bf8(x[2 * i], x[2 * i + 1]);
                }
            }
            if (last) continue;
            float ss = 0.f;
#pragma unroll
            for (int q = 0; q < 4; ++q) ss += x[q][0] * x[q][0] + x[q][1] * x[q][1] + x[q][2] * x[q][2] + x[q][3] * x[q][3];
            ss = wave_sum(ss);
            const float rstd = rsqrtf(ss * (1.f / D) + EPS);
#pragma unroll
            for (int i = 0; i < 2; ++i) {
                const f32x4 h0 = (x[2 * i] * rstd * vgpre[2 * i]) * vscale[2 * i] + vshift[2 * i];
                const f32x4 h1 = (x[2 * i + 1] * rstd * vgpre[2 * i + 1]) * vscale[2 * i + 1] + vshift[2 * i + 1];
                *(u32x4*)(hbuf + (size_t)row * D + i * 512 + lane * 8) = f32_to_bf8(h0, h1);
            }
        }
    }
}

DI void store_pair16(bf16_t* rowp, u32x2 A, u32x2 B, int g) {
    auto r0 = __builtin_amdgcn_permlane16_swap(A[0], B[0], false, false);
    auto r1 = __builtin_amdgcn_permlane16_swap(A[1], B[1], false, false);
    u32x4 o; o[0] = r0[0]; o[1] = r1[0]; o[2] = r0[1]; o[3] = r1[1];
    *(u32x4*)(rowp + ((g & 1) ? 16 + (g - 1) * 4 : g * 4)) = o;
}
enum { EPI_F32 = 0, EPI_QKV_DIFF = 1, EPI_QKV_SWA = 2, EPI_GU = 3 };

template <int EPI>
__device__ void gemm_phase(const Params& p, const bf16_t* __restrict__ A, const bf16_t* __restrict__ Bt, const int N, const int K, char* lds) {
    const int tid = threadIdx.x, lane = tid & 63, w = __builtin_amdgcn_readfirstlane(tid >> 6), wr = w >> 1, wc = w & 1, lr = lane & 15, g = lane >> 4;
    const int nN = N >> 7, ntiles = 32 * nN, nk = K >> 6;
    const int rin = lane >> 3, chp = lane & 7;
    const unsigned loffE = (unsigned)(rin * K + ((chp ^ (rin >> 1)) << 3)) * 2u;
    const unsigned loffO = (unsigned)(rin * K + ((chp ^ (rin >> 1) ^ 4) << 3)) * 2u;
    const int fsw = lr >> 1;
    const int half = w >> 2;
#define GEMM_STAGE(ga_, gb_, kt_, buf_) do { \
        char* _d = lds + (buf_) * 49152; \
        const size_t _k = (size_t)(kt_) * 64; \
        unsigned _lE = loffE, _lO = loffO; asm volatile("" : "+v"(_lE), "+v"(_lO)); \
        _Pragma("unroll") for (int _i = 0; _i < 4; ++_i) { \
            const char* _b = (const char*)((ga_) + (size_t)(w * 32 + _i * 8) * K + _k); \
            __builtin_amdgcn_global_load_lds((const unsigned*)(_b + ((_i & 1) ? _lO : _lE)), (__attribute__((address_space(3))) unsigned*)(_d + w * 4096 + _i * 1024), 16, 0, 0); } \
        _Pragma("unroll") for (int _i = 0; _i < 2; ++_i) { \
            const char* _b = (const char*)((gb_) + (size_t)(w * 16 + _i * 8) * K + _k); \
            __builtin_amdgcn_global_load_lds((const unsigned*)(_b + ((_i & 1) ? _lO : _lE)), (__attribute__((address_space(3))) unsigned*)(_d + 32768 + w * 2048 + _i * 1024), 16, 0, 0); } \
    } while (0)
#define GEMM_PIECE(ga_, gb_, kt_, buf_, pc_) do { \
        char* _d = lds + (buf_) * 49152; \
        const size_t _k = (size_t)(kt_) * 64; \
        unsigned _l = ((pc_) & 1) ? loffO : loffE; asm volatile("" : "+v"(_l)); \
        if ((pc_) < 4) { const char* _b = (const char*)((ga_) + (size_t)(w * 32 + (pc_) * 8) * K + _k); \
            __builtin_amdgcn_global_load_lds((const unsigned*)(_b + _l), (__attribute__((address_space(3))) unsigned*)(_d + w * 4096 + (pc_) * 1024), 16, 0, 0); } \
        else { const char* _b = (const char*)((gb_) + (size_t)(w * 16 + ((pc_) - 4) * 8) * K + _k); \
            __builtin_amdgcn_global_load_lds((const unsigned*)(_b + _l), (__attribute__((address_space(3))) unsigned*)(_d + 32768 + w * 2048 + ((pc_) - 4) * 1024), 16, 0, 0); } \
    } while (0)
    int t = blockIdx.x;
    if (t >= ntiles) return;
    int cur = 0;
    {
        const bf16_t* ga = A + (size_t)((t & 31) * 256) * K;
        const bf16_t* gb = Bt + (size_t)((t >> 5) * 128) * K;
        __syncthreads();
        GEMM_STAGE(ga, gb, 0, 0);
        GEMM_STAGE(ga, gb, 1, 1);
    }
    bool first = true;
    for (; t < ntiles; t += gridDim.x) {
        const int pm = t & 31, pn = t >> 5;
        const int m0 = pm * 256, n0 = pn * 128;
        f32x4 acc[4][4];
#pragma unroll
        for (int i = 0; i < 4; ++i)
#pragma unroll
            for (int j = 0; j < 4; ++j) acc[i][j] = (f32x4){0.f, 0.f, 0.f, 0.f};
        const bf16_t* ga = A + (size_t)m0 * K;
        const bf16_t* gb = Bt + (size_t)n0 * K;
        const int tn = t + gridDim.x;
        const bool has_next = tn < ntiles;
        const bf16_t* ga2 = A + (size_t)((tn & 31) * 256) * K;
        const bf16_t* gb2 = Bt + (size_t)((tn >> 5) * 128) * K;
        bf16x8 af[2][4], bfr[2][4];
#define GEMM_READ() do { \
            _Pragma("unroll") for (int ks = 0; ks < 2; ++ks) { \
                const int coff = ((ks * 4 + g) ^ fsw) << 4; \
                _Pragma("unroll") for (int mt = 0; mt < 4; ++mt) af[ks][mt] = *(const bf16x8*)(sa + (wr * 64 + mt * 16 + lr) * 128 + coff); \
                _Pragma("unroll") for (int nt = 0; nt < 4; ++nt) bfr[ks][nt] = *(const bf16x8*)(sb + (wc * 64 + nt * 16 + lr) * 128 + coff); \
            } } while (0)
#define GEMM_MMA() do { \
            _Pragma("unroll") for (int ks = 0; ks < 2; ++ks) \
                _Pragma("unroll") for (int mt = 0; mt < 4; ++mt) \
                    _Pragma("unroll") for (int nt = 0; nt < 4; ++nt) acc[mt][nt] = MFMA16(bfr[ks][nt], af[ks][mt], acc[mt][nt]); \
            } while (0)
#define GEMM_MMA_DMA(kt_) do { \
            const int slot2 = (cur == 0) ? 2 : cur - 1; \
            const bool _own = (kt_) + 2 < nk; const bool _any = _own || has_next; \
            const bf16_t* _ga = _own ? ga : ga2; const bf16_t* _gb = _own ? gb : gb2; const int _kk = _own ? (kt_) + 2 : (kt_) + 2 - nk; \
            _Pragma("unroll") for (int ks = 0; ks < 2; ++ks) \
                _Pragma("unroll") for (int mt = 0; mt < 4; ++mt) { \
                    _Pragma("unroll") for (int nt = 0; nt < 4; ++nt) acc[mt][nt] = MFMA16(bfr[ks][nt], af[ks][mt], acc[mt][nt]); \
                    const int _g = ks * 4 + mt; \
                    if ((_g == 1 || _g == 3 || _g == 5) && _any) { __builtin_amdgcn_sched_barrier(0); GEMM_PIECE(_ga, _gb, _kk, slot2, (_g - 1) >> 1); __builtin_amdgcn_sched_barrier(0); } \
                } \
            } while (0)
#define GEMM_SLOT_A(kt_) do { \
            if ((kt_) == 0) { if (first) asm volatile("s_waitcnt vmcnt(6) lgkmcnt(0)" ::: "memory"); else asm volatile("s_waitcnt lgkmcnt(0)" ::: "memory"); } \
            else if ((kt_) + 1 < nk || has_next) asm volatile("s_waitcnt vmcnt(6) lgkmcnt(0)" ::: "memory"); \
            else asm volatile("s_waitcnt vmcnt(0) lgkmcnt(0)" ::: "memory"); \
            __builtin_amdgcn_sched_barrier(0); __builtin_amdgcn_s_barrier(); __builtin_amdgcn_sched_barrier(0); \
            asm volatile("" ::: "memory"); \
        } while (0)
#define GEMM_MID_BAR() do { \
            asm volatile("s_waitcnt lgkmcnt(0)" ::: "memory"); \
            __builtin_amdgcn_sched_barrier(0); __builtin_amdgcn_s_barrier(); __builtin_amdgcn_sched_barrier(0); \
            asm volatile("" ::: "memory"); \
        } while (0)
#define GEMM_REST(kt_) do { \
            asm volatile("s_waitcnt lgkmcnt(0)" ::: "memory"); \
            __builtin_amdgcn_sched_barrier(0); \
            const int slot2 = (cur == 0) ? 2 : cur - 1; \
            const bool _own = (kt_) + 2 < nk; \
            if (_own || has_next) { \
                const bf16_t* _ga = _own ? ga : ga2; const bf16_t* _gb = _own ? gb : gb2; const int _kk = _own ? (kt_) + 2 : (kt_) + 2 - nk; \
                GEMM_PIECE(_ga, _gb, _kk, slot2, 3); GEMM_PIECE(_ga, _gb, _kk, slot2, 4); GEMM_PIECE(_ga, _gb, _kk, slot2, 5); } \
            __builtin_amdgcn_sched_barrier(0); \
        } while (0)
        if (half == 0) {
            for (int kt = 0; kt < nk; ++kt) {
                GEMM_SLOT_A(kt);
                const char* sa = lds + cur * 49152;
                const char* sb = sa + 32768;
                GEMM_READ();
                GEMM_REST(kt);
                GEMM_MID_BAR();
                GEMM_MMA_DMA(kt);
                cur = (cur == 2) ? 0 : cur + 1;
            }
        } else {
            for (int kt = 0; kt < nk; ++kt) {
                GEMM_SLOT_A(kt);
                if (kt > 0) GEMM_MMA_DMA(kt);
                else { const int slot2 = (cur == 0) ? 2 : cur - 1; GEMM_PIECE(ga, gb, 2, slot2, 0); GEMM_PIECE(ga, gb, 2, slot2, 1); GEMM_PIECE(ga, gb, 2, slot2, 2); }
                GEMM_MID_BAR();
                const char* sa = lds + cur * 49152;
                const char* sb = sa + 32768;
                GEMM_READ();
                GEMM_REST(kt);
                cur = (cur == 2) ? 0 : cur + 1;
            }
            asm volatile("s_waitcnt lgkmcnt(0)" ::: "memory");
            GEMM_MMA();
        }
#undef GEMM_REST
#undef GEMM_SLOT_A
#undef GEMM_MID_BAR
        if (has_next) asm volatile("s_waitcnt vmcnt(6)" ::: "memory");
        first = false;
#undef GEMM_READ
#undef GEMM_MMA
#undef GEMM_MMA_DMA
        const int mbase = m0 + wr * 64 + lr;
        const int nbase = n0 + wc * 64 + g * 4;
        if (EPI == EPI_F32) {
            bf16_t* Y = (bf16_t*)(p.ws + OFF_Y);
#pragma unroll
            for (int mt = 0; mt < 4; ++mt)
#pragma unroll
                for (int np = 0; np < 2; ++np) {
                    const f32x4 v0 = acc[mt][2 * np], v1 = acc[mt][2 * np + 1];
                    u32x2 a, b; a[0] = pack2(v0[0], v0[1]); a[1] = pack2(v0[2], v0[3]); b[0] = pack2(v1[0], v1[1]); b[1] = pack2(v1[2], v1[3]);
                    store_pair16(Y + (size_t)(mbase + mt * 16) * N + n0 + wc * 64 + np * 32, a, b, g);
                }
        } else if (EPI == EPI_GU) {
            bf16_t* U = (bf16_t*)(p.ws + OFF_U);
#pragma unroll
            for (int mt = 0; mt < 4; ++mt) {
                u32x2 o[2];
#pragma unroll
                for (int nt = 0; nt < 2; ++nt) {
                    const f32x4 gt = acc[mt][nt], up = acc[mt][nt + 2];
                    o[nt][0] = pack2(silu_f(gt[0]) * up[0], silu_f(gt[1]) * up[1]);
                    o[nt][1] = pack2(silu_f(gt[2]) * up[2], silu_f(gt[3]) * up[3]);
                }
                store_pair16(U + (size_t)(mbase + mt * 16) * DFF + pn * 64 + wc * 32, o[0], o[1], g);
            }
        } else {
            const int ncol0 = n0 + wc * 64;
            int sec, cofs, pitch;
            if (EPI == EPI_QKV_DIFF) { sec = ncol0 >> 10; cofs = ncol0 & 1023; pitch = 1024; }
            else { sec = ncol0 < 1024 ? 0 : (ncol0 < 1280 ? 1 : 2); cofs = sec == 0 ? ncol0 : (sec == 1 ? ncol0 - 1024 : ncol0 - 1280); pitch = sec == 0 ? 1024 : 256; }
            const bool latent = m0 >= NPROMPT;
            if (latent && sec < 2) {
                const float* rt = (const float*)(p.ws + OFF_ROPE);
#pragma unroll
                for (int mt = 0; mt < 4; ++mt) {
                    const int tl = (mbase + mt * 16 - NPROMPT) & 2047;
                    const int prow = tl >> 6, pcol = tl & 63;
                    const f32x4 r0 = *(const f32x4*)(rt + (prow * 16 + g * 4) * 2), r1 = *(const f32x4*)(rt + (prow * 16 + g * 4) * 2 + 4);
                    const f32x4 c0 = *(const f32x4*)(rt + (pcol * 16 + g * 4) * 2), c1 = *(const f32x4*)(rt + (pcol * 16 + g * 4) * 2 + 4);
                    const float cr[4] = {r0[0], r0[2], r1[0], r1[2]}, sr[4] = {r0[1], r0[3], r1[1], r1[3]};
                    const float cc[4] = {c0[0], c0[2], c1[0], c1[2]}, sc[4] = {c0[1], c0[3], c1[1], c1[3]};
#pragma unroll
                    for (int r = 0; r < 4; ++r) {
                        const float x1 = acc[mt][0][r], x2 = acc[mt][1][r], x3 = acc[mt][2][r], x4 = acc[mt][3][r];
                        acc[mt][0][r] = x1 * cr[r] - x2 * sr[r];
                        acc[mt][1][r] = x2 * cr[r] + x1 * sr[r];
                        acc[mt][2][r] = x3 * cc[r] - x4 * sc[r];
                        acc[mt][3][r] = x4 * cc[r] + x3 * sc[r];
                    }
                }
            }
            bf16_t* dstb = (bf16_t*)(p.ws + (sec == 0 ? OFF_Q : (sec == 1 ? OFF_K : OFF_V)));
            float* dstf = nullptr;
            if (!latent && sec > 0) {
                if (EPI == EPI_QKV_DIFF) dstf = p.out + (sec == 1 ? OUT_NDK : OUT_NDV);
                else dstf = p.out + (sec == 1 ? OUT_NSK : OUT_NSV);
            }
#pragma unroll
            for (int mt = 0; mt < 4; ++mt) {
                u32x2 o[4];
#pragma unroll
                for (int nt = 0; nt < 4; ++nt) {
                    const size_t idx = (size_t)(mbase + mt * 16) * pitch + cofs + g * 4 + nt * 16;
                    const f32x4 v = acc[mt][nt];
                    const f32x4 vs = (sec == 0) ? v * SC : v;
                    o[nt][0] = pack2(vs[0], vs[1]); o[nt][1] = pack2(vs[2], vs[3]);
                    if (dstf) *(f32x4*)(dstf + idx) = v;
                }
                bf16_t* rowp = dstb + (size_t)(mbase + mt * 16) * pitch + cofs;
                store_pair16(rowp, o[0], o[1], g);
                store_pair16(rowp + 32, o[2], o[3], g);
            }
        }
    }
}

#undef GEMM_STAGE
template <bool DIFF>
__device__ void attn_phase(const Params& p, char* lds) {
    constexpr int DV = DIFF ? 128 : 64, MT = DV / 16;
    constexpr int KBYTES = DIFF ? 16384 : 8192, VPITCH = DV * 2 + 32, BUFB = KBYTES + 64 * VPITCH;
    constexpr int NCH = DIFF ? 2 : 1, KSTEP = DIFF ? 32 : 64, PITCH = DIFF ? 1024 : 256;
    static_assert(2 * BUFB <= LDS_MAIN, "lds");
    const int tid = threadIdx.x, lane = tid & 63, w = tid >> 6, sub = w & 1, qg = w >> 1, lr = lane & 15, g = lane >> 4;
    const bf16_t* qbuf = (const bf16_t*)(p.ws + OFF_Q);
    const bf16_t* kbuf = (const bf16_t*)(p.ws + OFF_K);
    const bf16_t* vbuf = (const bf16_t*)(p.ws + OFF_V);
    bf16_t* obuf = (bf16_t*)(p.ws + OFF_O);
    float lam = 0.f;
    if (DIFF) {
        const float* dl = p.diff_lambda;
        const float a = wave_sum(dl[lane] * dl[64 + lane]), b = wave_sum(dl[128 + lane] * dl[192 + lane]);
        lam = __expf(a) - __expf(b) + 0.2f;
    }
    const int skey = DIFF ? (tid >> 4) : (tid >> 3), sch = DIFF ? (tid & 15) : (tid & 7);
    const int k_st = DIFF ? ((sch >> 3) * 8192 + skey * 128 + (((sch & 7) ^ ((skey >> 1) & 7)) << 4)) : (skey * 128 + ((sch ^ ((skey >> 1) & 7)) << 4));
    const int v_st = KBYTES + skey * VPITCH + sch * 16;
    const int g_off = skey * PITCH + sch * 8;

    const bool bg_first = (__popc(blockIdx.x) & 1) != 0;
    if (DIFF && bg_first) deferred_transposes(p, lds);
    for (int u = blockIdx.x; u < 512; u += gridDim.x) {
        int qtok0, n0t, t_lo, t_hi, vhead, qpos0 = 0;
        bool band = false;
        const bf16_t *K0 = nullptr, *V0 = nullptr, *K1, *V1;
        float m_init = 0.f, l_init = 0.f;
        if (DIFF) {
            int b, h, qb;
            if (u < 256) {
                const int xcd = u & 7, slot = u >> 3, bh = xcd * 2 + (slot >> 4);
                qb = slot & 15; b = bh >> 3; h = bh & 7;
                qtok0 = NPROMPT + b * 2048 + qb * 128;
                K0 = (const bf16_t*)(p.ws + OFF_CKD) + (size_t)(b * 512) * 1024 + h * 128;
                V0 = (const bf16_t*)(p.ws + OFF_CVD) + (size_t)(b * 512) * 1024 + h * 128;
                n0t = 8;
                K1 = kbuf + (size_t)(NPROMPT + b * 2048) * 1024 + h * 128;
                V1 = vbuf + (size_t)(NPROMPT + b * 2048) * 1024 + h * 128;
                t_lo = 0; t_hi = 32;
            } else {
                const int v = u - 256;
                b = v >> 4; h = (v >> 1) & 7; qb = v & 1;
                qtok0 = b * 256 + qb * 128;
                n0t = 0;
                K1 = kbuf + (size_t)(b * 256) * 1024 + h * 128;
                V1 = vbuf + (size_t)(b * 256) * 1024 + h * 128;
                t_lo = 0; t_hi = 4;
            }
            vhead = h * 2 + sub;
        } else {
            int b, kv, hp, qb;
            if (u < 256) {
                const int xcd = u & 7, slot = u >> 3;
                b = xcd >> 2; kv = xcd & 3; hp = slot >> 4; qb = slot & 15;
                qtok0 = NPROMPT + b * 2048 + qb * 128;
                K0 = (const bf16_t*)(p.ws + OFF_CKS) + (size_t)(b * 512) * 256 + kv * 64;
                V0 = (const bf16_t*)(p.ws + OFF_CVS) + (size_t)(b * 512) * 256 + kv * 64;
                n0t = 8;
                K1 = kbuf + (size_t)(NPROMPT + b * 2048) * 256 + kv * 64;
                V1 = vbuf + (size_t)(NPROMPT + b * 2048) * 256 + kv * 64;
                t_lo = 2 * qb - 2 < 0 ? 0 : 2 * qb - 2; t_hi = 2 * qb + 4 > 32 ? 32 : 2 * qb + 4;
                band = true; qpos0 = qb * 128;
            } else {
                const int v = u - 256;
                b = v >> 4; kv = (v >> 2) & 3; hp = (v >> 1) & 1; qb = v & 1;
                qtok0 = b * 256 + qb * 128;
                n0t = 0;
                K1 = kbuf + (size_t)(b * 256) * 256 + kv * 64;
                V1 = vbuf + (size_t)(b * 256) * 256 + kv * 64;
                t_lo = 0; t_hi = 4;
            }
            vhead = kv * 4 + hp * 2 + sub;
            m_init = p.swa_sink[vhead] * LOG2E;
            l_init = (g == 0) ? 1.f : 0.f;
        }
        const int ntile = n0t + (t_hi - t_lo);
        bf16x8 qf[2][2];
#pragma unroll
        for (int nt = 0; nt < 2; ++nt)
#pragma unroll
            for (int ks = 0; ks < 2; ++ks)
                qf[nt][ks] = *(const bf16x8*)(qbuf + (size_t)(qtok0 + qg * 32 + nt * 16 + lr) * 1024 + vhead * 64 + ks * 32 + g * 8);
        f32x4 O[MT][2];
#pragma unroll
        for (int i = 0; i < MT; ++i) { O[i][0] = (f32x4){0.f, 0.f, 0.f, 0.f}; O[i][1] = (f32x4){0.f, 0.f, 0.f, 0.f}; }
        float mrun[2] = {m_init, m_init};
        f32x4 Lacc[2] = {(f32x4){l_init, 0.f, 0.f, 0.f}, (f32x4){l_init, 0.f, 0.f, 0.f}};
        const short one_bf = (lr == 0) ? (short)0x3F80 : (short)0;
        const bf16x8 vones = {one_bf, one_bf, one_bf, one_bf, one_bf, one_bf, one_bf, one_bf};

        u32x4 rk[NCH], rv[NCH];
        {
            const bf16_t* kp = (n0t > 0) ? K0 : K1 + (size_t)t_lo * 64 * PITCH;
            const bf16_t* vp = (n0t > 0) ? V0 : V1 + (size_t)t_lo * 64 * PITCH;
#pragma unroll
            for (int c = 0; c < NCH; ++c) { rk[c] = *(const u32x4*)(kp + g_off + c * KSTEP * PITCH); rv[c] = *(const u32x4*)(vp + g_off + c * KSTEP * PITCH); }
#pragma unroll
            for (int c = 0; c < NCH; ++c) { *(u32x4*)(lds + k_st + c * KSTEP * 128) = rk[c]; *(u32x4*)(lds + v_st + c * KSTEP * VPITCH) = rv[c]; }
        }
        __syncthreads();
        for (int i = 0; i < ntile; ++i) {
            const bool more = i + 1 < ntile;
            if (more) {
                const int j = i + 1;
                const bf16_t* kp = (j < n0t) ? K0 + (size_t)j * 64 * PITCH : K1 + (size_t)(t_lo + j - n0t) * 64 * PITCH;
                const bf16_t* vp = (j < n0t) ? V0 + (size_t)j * 64 * PITCH : V1 + (size_t)(t_lo + j - n0t) * 64 * PITCH;
#pragma unroll
                for (int c = 0; c < NCH; ++c) { rk[c] = *(const u32x4*)(kp + g_off + c * KSTEP * PITCH); rv[c] = *(const u32x4*)(vp + g_off + c * KSTEP * PITCH); }
            }
            __builtin_amdgcn_sched_barrier(0);
            const char* buf = lds + (i & 1) * BUFB;
            const char* kb = buf + (DIFF ? sub * 8192 : 0);
            const char* vb = buf + KBYTES;
            f32x4 S[4][2];
            const f32x4 cin0 = {-mrun[0], -mrun[0], -mrun[0], -mrun[0]}, cin1 = {-mrun[1], -mrun[1], -mrun[1], -mrun[1]};
#pragma unroll
            for (int kt = 0; kt < 4; ++kt) {
                const bf16x8 kf = *(const bf16x8*)(kb + (kt * 16 + lr) * 128 + ((g ^ (lr >> 1)) << 4));
                S[kt][0] = MFMA16(kf, qf[0][0], cin0);
                S[kt][1] = MFMA16(kf, qf[1][0], cin1);
            }
#pragma unroll
            for (int kt = 0; kt < 4; ++kt) {
                const bf16x8 kf = *(const bf16x8*)(kb + (kt * 16 + lr) * 128 + (((4 + g) ^ (lr >> 1)) << 4));
                S[kt][0] = MFMA16(kf, qf[0][1], S[kt][0]);
                S[kt][1] = MFMA16(kf, qf[1][1], S[kt][1]);
            }
            const bool domask = band && i >= n0t && (unsigned)((t_lo + i - n0t) - (qpos0 >> 6)) >= 2u;
            const int kpos0 = (t_lo + i - n0t) * 64 + g * 4;
#pragma unroll
            for (int nt = 0; nt < 2; ++nt) {
                const int qpos = qpos0 + qg * 32 + nt * 16 + lr;
                float mx = -3.0e38f;
                if (domask) {
#pragma unroll
                    for (int kt = 0; kt < 4; ++kt)
#pragma unroll
                        for (int r = 0; r < 4; ++r) { const int dlt = qpos - (kpos0 + kt * 16 + r); if (dlt > 128 || dlt < -128) S[kt][nt][r] = -1e30f; }
                }
#pragma unroll
                for (int kt = 0; kt < 4; ++kt)
#pragma unroll
                    for (int r = 0; r < 4; ++r) mx = fmaxf(mx, S[kt][nt][r]);
                if (__builtin_amdgcn_ballot_w64((mx > 8.f) || (DIFF && i == 0)) != 0ull) {
                    mx = rows_max(mx);
                    const bool raise = (mx > 8.f) || (DIFF && i == 0);
                    const float delta = raise ? fmaxf(mx, -100.f) : 0.f;
                    const float alpha = __builtin_amdgcn_exp2f(-delta);
                    mrun[nt] += delta;
                    Lacc[nt] = Lacc[nt] * alpha;
#pragma unroll
                    for (int mt = 0; mt < MT; ++mt) O[mt][nt] = O[mt][nt] * alpha;
#pragma unroll
                    for (int kt = 0; kt < 4; ++kt) S[kt][nt] = S[kt][nt] - delta;
                }
#pragma unroll
                for (int kt = 0; kt < 4; ++kt)
#pragma unroll
                    for (int r = 0; r < 4; ++r) S[kt][nt][r] = __builtin_amdgcn_exp2f(S[kt][nt][r]);
            }
#pragma unroll
            for (int ks2 = 0; ks2 < 2; ++ks2) {
                bf16x8 pf[2];
#pragma unroll
                for (int nt = 0; nt < 2; ++nt) {
                    u32x4 pk;
                    pk[0] = pack2(S[2 * ks2][nt][0], S[2 * ks2][nt][1]); pk[1] = pack2(S[2 * ks2][nt][2], S[2 * ks2][nt][3]);
                    pk[2] = pack2(S[2 * ks2 + 1][nt][0], S[2 * ks2 + 1][nt][1]); pk[3] = pack2(S[2 * ks2 + 1][nt][2], S[2 * ks2 + 1][nt][3]);
                    pf[nt] = __builtin_bit_cast(bf16x8, pk);
                    Lacc[nt] = MFMA16(vones, pf[nt], Lacc[nt]);
                }
                const char* vrow = vb + (ks2 * 32 + g * 4 + (lr >> 2)) * VPITCH + (lr & 3) * 8;
#pragma unroll
                for (int mt = 0; mt < MT; ++mt) {
                    const s16x4 v0 = __builtin_amdgcn_ds_read_tr16_b64_v4i16((s16x4 __attribute__((address_space(3)))*)(vrow + mt * 32));
                    const s16x4 v1 = __builtin_amdgcn_ds_read_tr16_b64_v4i16((s16x4 __attribute__((address_space(3)))*)(vrow + mt * 32 + 16 * VPITCH));
                    const bf16x8 vf = __builtin_shufflevector(v0, v1, 0, 1, 2, 3, 4, 5, 6, 7);
                    O[mt][0] = MFMA16(vf, pf[0], O[mt][0]);
                    O[mt][1] = MFMA16(vf, pf[1], O[mt][1]);
                }
            }
            if (more) {
                char* nb = lds + ((i + 1) & 1) * BUFB;
#pragma unroll
                for (int c = 0; c < NCH; ++c) { *(u32x4*)(nb + k_st + c * KSTEP * 128) = rk[c]; *(u32x4*)(nb + v_st + c * KSTEP * VPITCH) = rv[c]; }
            }
            __syncthreads();
        }
#pragma unroll
        for (int nt = 0; nt < 2; ++nt) {
            const float l = rows_sum(Lacc[nt][0]);
            const float inv = __builtin_amdgcn_rcpf(l);
#pragma unroll
            for (int mt = 0; mt < MT; ++mt) O[mt][nt] = O[mt][nt] * inv;
        }
        if (DIFF) {
            float* ex = (float*)lds;
            if (sub == 1) {
#pragma unroll
                for (int nt = 0; nt < 2; ++nt)
#pragma unroll
                    for (int mt = 0; mt < MT; ++mt)
#pragma unroll
                        for (int r = 0; r < 4; ++r) ex[((qg * 2 + nt) * 32 + mt * 4 + r) * 64 + lane] = O[mt][nt][r];
            }
            __syncthreads();
            if (sub == 0) {
                const float* gs = p.diff_subln_g;
                const int h = vhead >> 1;
#pragma unroll
                for (int nt = 0; nt < 2; ++nt) {
                    float ss = 0.f;
#pragma unroll
                    for (int mt = 0; mt < MT; ++mt)
#pragma unroll
                        for (int r = 0; r < 4; ++r) {
                            const float d = O[mt][nt][r] - lam * ex[((qg * 2 + nt) * 32 + mt * 4 + r) * 64 + lane];
                            O[mt][nt][r] = d;
                            ss += d * d;
                        }
                    ss = rows_sum(ss);
                    const float rstd = rsqrtf(ss * (1.f / 128.f) + EPS) * 0.8f;
                    bf16_t* orow = obuf + (size_t)(qtok0 + qg * 32 + nt * 16 + lr) * 1024 + h * 128;
#pragma unroll
                    for (int mp = 0; mp < MT / 2; ++mp) {
                        u32x2 o[2];
#pragma unroll
                        for (int e = 0; e < 2; ++e) {
                            const int mt = 2 * mp + e;
                            const f32x4 gg = *(const f32x4*)(gs + mt * 16 + g * 4);
                            const f32x4 v = O[mt][nt] * rstd * gg;
                            o[e][0] = pack2(v[0], v[1]); o[e][1] = pack2(v[2], v[3]);
                        }
                        store_pair16(orow + mp * 32, o[0], o[1], g);
                    }
                }
            }
            __syncthreads();
        } else {
#pragma unroll
            for (int nt = 0; nt < 2; ++nt) {
                bf16_t* orow = obuf + (size_t)(qtok0 + qg * 32 + nt * 16 + lr) * 1024 + vhead * 64;
#pragma unroll
                for (int mp = 0; mp < MT / 2; ++mp) {
                    const f32x4 v0 = O[2 * mp][nt], v1 = O[2 * mp + 1][nt];
                    u32x2 a, b; a[0] = pack2(v0[0], v0[1]); a[1] = pack2(v0[2], v0[3]); b[0] = pack2(v1[0], v1[1]); b[1] = pack2(v1[2], v1[3]);
                    store_pair16(orow + mp * 32, a, b, g);
                }
            }
        }
    }
    if (DIFF && !bg_first) deferred_transposes(p, lds);
}

__global__ void __launch_bounds__(512, 2) mega(Params p) {
    extern __shared__ __attribute__((aligned(16))) char lds[];
    cg::grid_group grid = cg::this_grid();
    if (p.ws == nullptr) grid.sync();
    volatile LAS unsigned* st = (volatile LAS unsigned*)(lds + LDS_MAIN);
    if (threadIdx.x == 0) { st[0] = 0u; st[1] = 0u; st[2] = 0u; st[3] = 0u; }
    __syncthreads();
    const XcdBarrier xb = xcd_barrier_post((unsigned*)(p.ws + OFF_BAR), st);
    const bf16_t* hbuf = (const bf16_t*)(p.ws + OFF_H);
    const bf16_t* obuf = (const bf16_t*)(p.ws + OFF_O);
    const bf16_t* ubuf = (const bf16_t*)(p.ws + OFF_U);
    prepass(p, lds);
    xcd_barrier(xb);
    rowphase<0>(p, 0);
    xcd_barrier(xb);
    gemm_phase<EPI_QKV_DIFF>(p, hbuf, (const bf16_t*)(p.ws + OFF_WQKV0), 3072, 1024, lds);
    xcd_barrier(xb);
    attn_phase<true>(p, lds);
    xcd_barrier(xb);
    gemm_phase<EPI_F32>(p, obuf, (const bf16_t*)(p.ws + OFF_WO0), 1024, 1024, lds);
    xcd_barrier(xb);
    rowphase<1>(p, 0);
    xcd_barrier(xb);
    gemm_phase<EPI_GU>(p, hbuf, (const bf16_t*)(p.ws + OFF_WGU0), 5632, 1024, lds);
    xcd_barrier(xb);
    gemm_phase<EPI_F32>(p, ubuf, (const bf16_t*)(p.ws + OFF_WD0), 1024, 2816, lds);
    xcd_barrier(xb);
    rowphase<2>(p, 0);
    xcd_barrier(xb);
    gemm_phase<EPI_QKV_SWA>(p, hbuf, (const bf16_t*)(p.ws + OFF_WQKV1), 1536, 1024, lds);
    xcd_barrier(xb);
    attn_phase<false>(p, lds);
    xcd_barrier(xb);
    gemm_phase<EPI_F32>(p, obuf, (const bf16_t*)(p.ws + OFF_WO1), 1024, 1024, lds);
    xcd_barrier(xb);
    rowphase<1>(p, 1);
    xcd_barrier(xb);
    gemm_phase<EPI_GU>(p, hbuf, (const bf16_t*)(p.ws + OFF_WGU1), 5632, 1024, lds);
    xcd_barrier(xb);
    gemm_phase<EPI_F32>(p, ubuf, (const bf16_t*)(p.ws + OFF_WD1), 1024, 2816, lds);
    xcd_barrier(xb);
    rowphase<2>(p, 1);
}

extern "C" void kernel_launch(void* const* d_in, const int* in_sizes, int n_in, void* d_out, int out_size, void* d_ws, size_t ws_size, hipStream_t stream) {
    static int grid_blocks = 0;
    if (grid_blocks == 0) {
        if (n_in != 21 || ws_size < WS_END) { fprintf(stderr, "kernel_launch: unexpected inputs (n_in %d, ws %zu < %zu)\n", n_in, ws_size, (size_t)WS_END); grid_blocks = -1; return; }
        int dev = 0, cus = 0, per_cu = 0;
        (void)hipGetDevice(&dev);
        (void)hipDeviceGetAttribute(&cus, hipDeviceAttributeMultiprocessorCount, dev);
        if (hipFuncSetAttribute((const void*)mega, hipFuncAttributeMaxDynamicSharedMemorySize, LDS_BYTES) != hipSuccess) { fprintf(stderr, "kernel_launch: hipFuncSetAttribute failed\n"); grid_blocks = -1; return; }
        if (hipOccupancyMaxActiveBlocksPerMultiprocessor(&per_cu, (const void*)mega, NTHR, LDS_BYTES) != hipSuccess || per_cu < 1) { fprintf(stderr, "kernel_launch: occupancy query failed (%d)\n", per_cu); grid_blocks = -1; return; }
        if (per_cu > 1) per_cu = 1;
        grid_blocks = cus * per_cu;
        fprintf(stderr, "kernel_launch: %d CUs x %d = %d workgroups\n", cus, per_cu, grid_blocks);
    }
    if (grid_blocks < 0) return;
    if (hipMemsetAsync((char*)d_ws + OFF_BAR, 0, XCD_BAR_WORDS * 4, stream) != hipSuccess) { fprintf(stderr, "kernel_launch: memset failed\n"); return; }
    Params p{};
    const float** pp = (const float**)&p;
    for (int i = 0; i < 21; ++i) pp[i] = (const float*)d_in[i];
    p.out = (float*)d_out;
    p.ws = (char*)d_ws;
    void* args[] = {&p};
    hipError_t e = hipLaunchCooperativeKernel((const void*)mega, dim3(grid_blocks), dim3(NTHR), args, LDS_BYTES, stream);
    if (e != hipSuccess) fprintf(stderr, "cooperative launch failed: %s (grid %d)\n", hipGetErrorString(e), grid_blocks);
}
```

```cpp
#include <hip/hip_runtime.h>
#include <hip/hip_cooperative_groups.h>
#include <cstdint>
#include <cstdio>
namespace cg = cooperative_groups;

typedef unsigned short bf16_t;
typedef short bf16x8 __attribute__((ext_vector_type(8)));
typedef short s16x4 __attribute__((ext_vector_type(4)));
typedef float f32x4 __attribute__((ext_vector_type(4)));
typedef float f32x2 __attribute__((ext_vector_type(2)));
typedef unsigned u32x4 __attribute__((ext_vector_type(4)));
typedef unsigned u32x2 __attribute__((ext_vector_type(2)));
typedef __bf16 bf2_t __attribute__((ext_vector_type(2)));
#define DI __device__ __forceinline__
#define MFMA16(a, b, c) __builtin_amdgcn_mfma_f32_16x16x32_bf16((a), (b), (c), 0, 0, 0)

constexpr int D = 1024, NTOK = 8192, NPROMPT = 4096, DFF = 2816;
constexpr float EPS = 1e-6f, LOG2E = 1.4426950408889634f, SC = 0.125f * 1.4426950408889634f;

constexpr size_t OFF_MOD = 0;
constexpr size_t OFF_ROPE = 147456;
constexpr size_t OFF_BAR = 163840;
constexpr size_t OFF_WQKV0 = 1u << 20;
constexpr size_t OFF_WO0 = OFF_WQKV0 + 3072ull * 1024 * 2;
constexpr size_t OFF_WGU0 = OFF_WO0 + 1024ull * 1024 * 2;
constexpr size_t OFF_WD0 = OFF_WGU0 + 5632ull * 1024 * 2;
constexpr size_t OFF_WQKV1 = OFF_WD0 + 1024ull * 2816 * 2;
constexpr size_t OFF_WO1 = OFF_WQKV1 + 1536ull * 1024 * 2;
constexpr size_t OFF_WGU1 = OFF_WO1 + 1024ull * 1024 * 2;
constexpr size_t OFF_WD1 = OFF_WGU1 + 5632ull * 1024 * 2;
constexpr size_t OFF_CKD = OFF_WD1 + 1024ull * 2816 * 2;
constexpr size_t OFF_CVD = OFF_CKD + 1024ull * 1024 * 2;
constexpr size_t OFF_CKS = OFF_CVD + 1024ull * 1024 * 2;
constexpr size_t OFF_CVS = OFF_CKS + 1024ull * 256 * 2;
constexpr size_t OFF_H = OFF_CVS + 1024ull * 256 * 2;
constexpr size_t OFF_Q = OFF_H + 8192ull * 1024 * 2;
constexpr size_t OFF_K = OFF_Q + 8192ull * 1024 * 2;
constexpr size_t OFF_V = OFF_K + 8192ull * 1024 * 2;
constexpr size_t OFF_U = OFF_Q;
constexpr size_t OFF_O = OFF_V + 8192ull * 1024 * 2;
constexpr size_t OFF_Y = OFF_O + 8192ull * 1024 * 2;
constexpr size_t OFF_X = OFF_Y + 8192ull * 1024 * 4;
constexpr size_t WS_END = OFF_X + 8192ull * 1024 * 4;
static_assert(8192ull * 2816 * 2 <= 3 * 8192ull * 1024 * 2, "U overlay");

constexpr size_t OUT_Y = 0, OUT_NDK = 8388608, OUT_NDV = 12582912, OUT_NSK = 16777216, OUT_NSV = 17825792;

constexpr int NTHR = 512, NWAVE = 8;
constexpr int LDS_MAIN = 147456, LDS_BYTES = LDS_MAIN + 16;

struct Params {
    const float *x_prompt, *x_sample, *cdk, *cdv, *csk, *csv, *c, *c_ctx, *w_mod, *b_mod, *norm_g, *w_qkv_diff, *diff_lambda, *diff_subln_g,
        *w_o_diff, *w_qkv_swa, *swa_sink, *w_o_swa, *w_gate, *w_up, *w_down;
    float* out;
    char* ws;
};

DI unsigned pack2(float a, float b) { bf2_t v; v[0] = (__bf16)a; v[1] = (__bf16)b; return __builtin_bit_cast(unsigned, v); }
DI float wave_sum(float v) {
#pragma unroll
    for (int o = 32; o > 0; o >>= 1) v += __shfl_xor(v, o);
    return v;
}
DI float rows_max(float v) {
    auto a = __builtin_amdgcn_permlane16_swap(__float_as_uint(v), __float_as_uint(v), false, false);
    v = fmaxf(__uint_as_float(a[0]), __uint_as_float(a[1]));
    auto b = __builtin_amdgcn_permlane32_swap(__float_as_uint(v), __float_as_uint(v), false, false);
    return fmaxf(__uint_as_float(b[0]), __uint_as_float(b[1]));
}
DI float rows_sum(float v) {
    auto a = __builtin_amdgcn_permlane16_swap(__float_as_uint(v), __float_as_uint(v), false, false);
    v = __uint_as_float(a[0]) + __uint_as_float(a[1]);
    auto b = __builtin_amdgcn_permlane32_swap(__float_as_uint(v), __float_as_uint(v), false, false);
    return __uint_as_float(b[0]) + __uint_as_float(b[1]);
}
DI float silu_f(float x) { return x * __builtin_amdgcn_rcpf(1.f + __expf(-x)); }


#define XB_TMO      128
#define XB_XCNT(j)  (256  + 64 * (j))
#define XB_XSUB(j)  (1280 + 64 * (j))
#define XB_XGEN(j)  (2304 + 64 * (j))
#define XB_TOP      3328
#define XB_TOPGEN   3392
#define XCD_BAR_WORDS 3456
#define XB_SPIN_CAP (1u << 18)
#define LAS __attribute__((address_space(3)))
DI unsigned xb_ld(unsigned* p) { return __hip_atomic_load(p, __ATOMIC_RELAXED, __HIP_MEMORY_SCOPE_AGENT); }
DI unsigned xb_add(unsigned* p, unsigned v) { return __hip_atomic_fetch_add(p, v, __ATOMIC_RELAXED, __HIP_MEMORY_SCOPE_AGENT); }
DI unsigned xb_xcc_id() { return (unsigned)__builtin_amdgcn_s_getreg((3 << 11) | 20) & 0xFu; }
#define XB_SPIN(cond, bar) do { unsigned _sp = 0; while (cond) { __builtin_amdgcn_s_sleep(1); \
    if ((++_sp & 255u) == 0u) { if (xb_ld(&(bar)[XB_TMO])) break; if (_sp > XB_SPIN_CAP) { atomicAdd(&(bar)[XB_TMO], 1u); break; } } } } while (0)
struct XcdBarrier { unsigned* bar; unsigned x; volatile LAS unsigned* st; };
DI XcdBarrier xcd_barrier_post(unsigned* bar, volatile LAS unsigned* st) {
    XcdBarrier b; b.bar = bar; b.x = xb_xcc_id(); b.st = st;
    if (threadIdx.x == 0) (void)xb_add(&bar[XB_XCNT(b.x)], 1u);
    return b;
}
DI void xcd_barrier_complete(unsigned* bar, unsigned x, unsigned& nloc, unsigned& nx) {
    const unsigned G = gridDim.x * gridDim.y * gridDim.z;
    unsigned sum, cnt, mine, sp = 0u;
    for (;;) {
        sum = 0u; cnt = 0u; mine = 0u;
#pragma unroll
        for (unsigned j = 0; j < 16; ++j) { const unsigned c = xb_ld(&bar[XB_XCNT(j)]); sum += c; cnt += (c > 0u) ? 1u : 0u; mine = (j == x) ? c : mine; }
        if (sum == G) break;
        __builtin_amdgcn_s_sleep(1);
        if ((++sp & 255u) == 0u) { if (xb_ld(&bar[XB_TMO])) break; if (sp > XB_SPIN_CAP) { atomicAdd(&bar[XB_TMO], 1u); break; } }
    }
    nloc = mine > 0u ? mine : 1u; nx = cnt > 0u ? cnt : 1u;
}
DI void xcd_barrier(const XcdBarrier& b) {
    asm volatile("s_waitcnt vmcnt(0)" ::: "memory");
    __syncthreads();
    if (threadIdx.x == 0) {
        unsigned* bar = b.bar;
        __builtin_amdgcn_s_waitcnt(0);
        unsigned nloc = b.st[0], nx = b.st[1];
        if (nloc == 0u) { xcd_barrier_complete(bar, b.x, nloc, nx); b.st[0] = nloc; b.st[1] = nx; }
        const unsigned old = xb_add(&bar[XB_XSUB(b.x)], 1u);
        const unsigned gen = old / nloc;
        if (old + 1u == (gen + 1u) * nloc) {
            __builtin_amdgcn_fence(__ATOMIC_RELEASE, "agent");
            asm volatile("s_waitcnt vmcnt(0)" ::: "memory");
            const unsigned og = xb_add(&bar[XB_TOP], 1u);
            const unsigned tg = og / nx;
            if (og + 1u == (tg + 1u) * nx) xb_add(&bar[XB_TOPGEN], 1u);
            else XB_SPIN(xb_ld(&bar[XB_TOPGEN]) == tg, bar);
            __builtin_amdgcn_fence(__ATOMIC_ACQUIRE, "agent");
            xb_add(&bar[XB_XGEN(b.x)], 1u);
            asm volatile("s_waitcnt vmcnt(0)" ::: "memory");
        } else {
            XB_SPIN(xb_ld(&bar[XB_XGEN(b.x)]) == gen, bar);
            __builtin_amdgcn_fence(__ATOMIC_ACQUIRE, "agent");
            asm volatile("s_waitcnt vmcnt(0)" ::: "memory");
        }
    }
    __syncthreads();
}

DI void transpose_item_wave(const float* __restrict__ src, int ld, int k0, int c0, bf16_t* __restrict__ dst, int K, int nrow0, float* scr, int lane) {
#pragma unroll 8
    for (int i = 0; i < 32; ++i) { const int kk = 2 * i + (lane >> 5); scr[kk * 33 + (lane & 31)] = src[(size_t)(k0 + kk) * ld + c0 + (lane & 31)]; }
    asm volatile("s_waitcnt lgkmcnt(0)" ::: "memory");
    const int c = lane & 7;
#pragma unroll
    for (int j = 0; j < 4; ++j) {
        const int n = (lane >> 3) + 8 * j;
        const float* r = scr + (8 * c) * 33 + n;
        u32x4 o;
        o[0] = pack2(r[0 * 33], r[1 * 33]); o[1] = pack2(r[2 * 33], r[3 * 33]); o[2] = pack2(r[4 * 33], r[5 * 33]); o[3] = pack2(r[6 * 33], r[7 * 33]);
        *(u32x4*)(dst + (size_t)(nrow0 + n) * K + k0 + 8 * c) = o;
    }
    asm volatile("s_waitcnt lgkmcnt(0)" ::: "memory");
}

DI void tr_block_item(const Params& p, int bi, char* lds) {
    const int tid = threadIdx.x;
    int ti = bi * NWAVE + (tid >> 6);
    const int l = ti >= 6272 ? 1 : 0; ti -= l * 6272;
    const int nq = l ? 1536 : 3072, i_qkv = 16 * (nq / 32);
    const float* src; const float* src2 = nullptr; int ld, K; bf16_t* dst; bool gu = false;
    if (ti < i_qkv) { src = l ? p.w_qkv_swa : p.w_qkv_diff; ld = nq; K = 1024; dst = (bf16_t*)(p.ws + (l ? OFF_WQKV1 : OFF_WQKV0)); }
    else if ((ti -= i_qkv) < 512) { src = l ? p.w_o_swa : p.w_o_diff; ld = 1024; K = 1024; dst = (bf16_t*)(p.ws + (l ? OFF_WO1 : OFF_WO0)); }
    else if ((ti -= 512) < 2816) { src = p.w_gate + (size_t)l * 1024 * 2816; src2 = p.w_up + (size_t)l * 1024 * 2816; ld = 2816; K = 1024; dst = (bf16_t*)(p.ws + (l ? OFF_WGU1 : OFF_WGU0)); gu = true; }
    else { ti -= 2816; src = p.w_down + (size_t)l * 2816 * 1024; ld = 1024; K = 2816; dst = (bf16_t*)(p.ws + (l ? OFF_WD1 : OFF_WD0)); }
    const int nkb = K / 64, kb = ti % nkb, nb = ti / nkb;
    int c0 = nb * 32;
    if (gu) { const int tile = nb >> 2, wc = (nb >> 1) & 1, isup = nb & 1; c0 = tile * 64 + wc * 32; if (isup) src = src2; }
    transpose_item_wave(src, ld, kb * 64, c0, dst, K, nb * 32, (float*)lds + (tid >> 6) * (64 * 33), tid & 63);
}
constexpr int TR_P0 = 192, TR_ALL = 1472;
__device__ void deferred_transposes(const Params& p, char* lds) {
    __syncthreads();
    for (int bi = TR_P0 + blockIdx.x; bi < TR_ALL; bi += gridDim.x) tr_block_item(p, bi, lds);
    __syncthreads();
}

__device__ void prepass(const Params& p, char* lds) {
    const int tid = threadIdx.x;
    constexpr int N_MOD = 192, N_ROPE = 2, N_TR = TR_P0, N_CACHE = 640;
    constexpr int TOTAL = N_MOD + N_ROPE + N_TR + N_CACHE;
    for (int it = blockIdx.x; it < TOTAL; it += gridDim.x) {
        if (it < N_MOD) {
            const int l = it / 96, n0 = (it % 96) * 64;
            float* sc = (float*)lds;
            float* red = sc + 3 * 1024;
            for (int e = tid; e < 3 * 1024; e += NTHR) {
                const int c = e >> 10, k = e & 1023;
                const float v = (c == 0) ? p.c_ctx[k] : p.c[(c - 1) * 1024 + k];
                sc[e] = silu_f(v);
            }
            __syncthreads();
            const int c4 = tid & 15, kg = tid >> 4;
            const float* w = p.w_mod + (size_t)l * 1024 * 6144 + (size_t)(kg * 32) * 6144 + n0 + c4 * 4;
            f32x4 a0 = {0.f, 0.f, 0.f, 0.f}, a1 = a0, a2 = a0;
#pragma unroll 8
            for (int k = 0; k < 32; ++k) {
                const f32x4 wv = *(const f32x4*)(w + (size_t)k * 6144);
                a0 += wv * sc[kg * 32 + k]; a1 += wv * sc[1024 + kg * 32 + k]; a2 += wv * sc[2048 + kg * 32 + k];
            }
            *(f32x4*)(red + (kg * 3 + 0) * 64 + c4 * 4) = a0; *(f32x4*)(red + (kg * 3 + 1) * 64 + c4 * 4) = a1; *(f32x4*)(red + (kg * 3 + 2) * 64 + c4 * 4) = a2;
            __syncthreads();
            if (tid < 192) {
                const int c = tid >> 6, cc = tid & 63;
                float s = p.b_mod[l * 6144 + n0 + cc];
#pragma unroll
                for (int q = 0; q < 32; ++q) s += red[(q * 3 + c) * 64 + cc];
                ((float*)(p.ws + OFF_MOD))[(l * 3 + c) * 6144 + n0 + cc] = s;
            }
            __syncthreads();
        } else if (it < N_MOD + N_ROPE) {
            float* rt = (float*)(p.ws + OFF_ROPE);
            const int e = (it - N_MOD) * NTHR + tid;
            const int pos = e >> 4, i = e & 15;
            const float inv = (float)exp2(-((double)i / 16.0) * 13.287712379549449);
            const float ang = (float)pos * inv;
            rt[e * 2] = (float)cos((double)ang);
            rt[e * 2 + 1] = (float)sin((double)ang);
        } else if (it < N_MOD + N_ROPE + N_TR) {
            tr_block_item(p, it - (N_MOD + N_ROPE), lds);
        } else {
            int ci = it - (N_MOD + N_ROPE + N_TR);
            const float* src; bf16_t* dst;
            if (ci < 256) { src = p.cdk; dst = (bf16_t*)(p.ws + OFF_CKD); }
            else if (ci < 512) { src = p.cdv; dst = (bf16_t*)(p.ws + OFF_CVD); ci -= 256; }
            else if (ci < 576) { src = p.csk; dst = (bf16_t*)(p.ws + OFF_CKS); ci -= 512; }
            else { src = p.csv; dst = (bf16_t*)(p.ws + OFF_CVS); ci -= 576; }
            const size_t e = (size_t)ci * 4096 + tid * 8;
            const f32x4 a = *(const f32x4*)(src + e), b = *(const f32x4*)(src + e + 4);
            u32x4 o; o[0] = pack2(a[0], a[1]); o[1] = pack2(a[2], a[3]); o[2] = pack2(b[0], b[1]); o[3] = pack2(b[2], b[3]);
            *(u32x4*)(dst + e) = o;
        }
    }
}

DI void bf8_to_f32(const u32x4 r, f32x4& a, f32x4& b) {
    a = (f32x4){__uint_as_float(r[0] << 16), __uint_as_float(r[0] & 0xffff0000u), __uint_as_float(r[1] << 16), __uint_as_float(r[1] & 0xffff0000u)};
    b = (f32x4){__uint_as_float(r[2] << 16), __uint_as_float(r[2] & 0xffff0000u), __uint_as_float(r[3] << 16), __uint_as_float(r[3] & 0xffff0000u)};
}
DI u32x4 f32_to_bf8(const f32x4 a, const f32x4 b) { u32x4 o; o[0] = pack2(a[0], a[1]); o[1] = pack2(a[2], a[3]); o[2] = pack2(b[0], b[1]); o[3] = pack2(b[2], b[3]); return o; }

template <int MODE>
__device__ void rowphase(const Params& p, int layer) {
    const int lane = threadIdx.x & 63, w = threadIdx.x >> 6;
    const float* mod = (const float*)(p.ws + OFF_MOD);
    bf16_t* xbuf = (bf16_t*)(p.ws + OFF_X);
    const bf16_t* ybuf = (const bf16_t*)(p.ws + OFF_Y);
    bf16_t* hbuf = (bf16_t*)(p.ws + OFF_H);
    constexpr int RB = 4;
    const bool last = (MODE == 2 && layer == 1);
    for (int rb = blockIdx.x * NWAVE + w; rb < NTOK / RB; rb += gridDim.x * NWAVE) {
        const int rowb = rb * RB;
        const int cond = rowb < NPROMPT ? 0 : 1 + ((rowb - NPROMPT) >> 11);
        const float* mrow = mod + (size_t)(layer * 3 + cond) * 6144;
        const int nl = (MODE == 2) ? layer + 1 : layer;
        const float* mrow2 = mod + (size_t)(nl * 3 + cond) * 6144;
        f32x4 vgpost[4], vgate[4], vgpre[4], vshift[4], vscale[4];
#pragma unroll
        for (int q = 0; q < 4; ++q) {
            const int o = (q >> 1) * 512 + lane * 8 + (q & 1) * 4;
            if (MODE != 0) {
                vgpost[q] = *(const f32x4*)(p.norm_g + (size_t)(layer * 4 + (MODE == 1 ? 1 : 3)) * D + o);
                vgate[q] = *(const f32x4*)(mrow + (MODE == 1 ? 2 : 5) * D + o);
            }
            if (!last) {
                vgpre[q] = *(const f32x4*)(p.norm_g + (size_t)(nl * 4 + (MODE == 1 ? 2 : 0)) * D + o);
                vshift[q] = *(const f32x4*)(mrow2 + (MODE == 1 ? 3 : 0) * D + o);
                vscale[q] = *(const f32x4*)(mrow2 + (MODE == 1 ? 4 : 1) * D + o) + 1.f;
            }
        }
#pragma unroll 2
        for (int j = 0; j < RB; ++j) {
            const int row = rowb + j;
            f32x4 x[4];
            if (MODE == 2 || layer == 1) {
#pragma unroll
                for (int i = 0; i < 2; ++i) bf8_to_f32(*(const u32x4*)(xbuf + (size_t)row * D + i * 512 + lane * 8), x[2 * i], x[2 * i + 1]);
            } else {
                const float* xin = row < NPROMPT ? p.x_prompt + (size_t)row * D : p.x_sample + (size_t)(row - NPROMPT) * D;
#pragma unroll
                for (int q = 0; q < 4; ++q) x[q] = *(const f32x4*)(xin + (q >> 1) * 512 + lane * 8 + (q & 1) * 4);
            }
            if (MODE != 0) {
                f32x4 y[4];
                float ss = 0.f;
#pragma unroll
                for (int i = 0; i < 2; ++i) bf8_to_f32(*(const u32x4*)(ybuf + (size_t)row * D + i * 512 + lane * 8), y[2 * i], y[2 * i + 1]);
#pragma unroll
                for (int q = 0; q < 4; ++q) ss += y[q][0] * y[q][0] + y[q][1] * y[q][1] + y[q][2] * y[q][2] + y[q][3] * y[q][3];
                ss = wave_sum(ss);
                const float rstd = rsqrtf(ss * (1.f / D) + EPS);
#pragma unroll
                for (int q = 0; q < 4; ++q) x[q] = x[q] + vgate[q] * (y[q] * rstd * vgpost[q]);
#pragma unroll
                for (int i = 0; i < 2; ++i) {
                    if (last) {
                        *(f32x4*)(p.out + OUT_Y + (size_t)row * D + i * 512 + lane * 8) = x[2 * i];
                        *(f32x4*)(p.out + OUT_Y + (size_t)row * D + i * 512 + lane * 8 + 4) = x[2 * i + 1];
                    } else *(u32x4*)(xbuf + (size_t)row * D + i * 512 + lane * 8) = f32_to_bf8(x[2 * i], x[2 * i + 1]);
                }
            }
            if (last) continue;
            float ss = 0.f;
#pragma unroll
            for (int q = 0; q < 4; ++q) ss += x[q][0] * x[q][0] + x[q][1] * x[q][1] + x[q][2] * x[q][2] + x[q][3] * x[q][3];
            ss = wave_sum(ss);
            const float rstd = rsqrtf(ss * (1.f / D) + EPS);
#pragma unroll
            for (int i = 0; i < 2; ++i) {
                const f32x4 h0 = (x[2 * i] * rstd * vgpre[2 * i]) * vscale[2 * i] + vshift[2 * i];
                const f32x4 h1 = (x[2 * i + 1] * rstd * vgpre[2 * i + 1]) * vscale[2 * i + 1] + vshift[2 * i + 1];
                *(u32x4*)(hbuf + (size_t)row * D + i * 512 + lane * 8) = f32_to_bf8(h0, h1);
            }
        }
    }
}

DI void store_pair16(bf16_t* rowp, u32x2 A, u32x2 B, int g) {
    auto r0 = __builtin_amdgcn_permlane16_swap(A[0], B[0], false, false);
    auto r1 = __builtin_amdgcn_permlane16_swap(A[1], B[1], false, false);
    u32x4 o; o[0] = r0[0]; o[1] = r1[0]; o[2] = r0[1]; o[3] = r1[1];
    *(u32x4*)(rowp + ((g & 1) ? 16 + (g - 1) * 4 : g * 4)) = o;
}
enum { EPI_F32 = 0, EPI_QKV_DIFF = 1, EPI_QKV_SWA = 2, EPI_GU = 3 };

template <int EPI>
__device__ void gemm_phase(const Params& p, const bf16_t* __restrict__ A, const bf16_t* __restrict__ Bt, const int N, const int K, char* lds) {
    const int tid = threadIdx.x, lane = tid & 63, w = __builtin_amdgcn_readfirstlane(tid >> 6), wr = w >> 1, wc = w & 1, lr = lane & 15, g = lane >> 4;
    const int nN = N >> 7, ntiles = 32 * nN, nk = K >> 6;
    const int rin = lane >> 3, chp = lane & 7;
    const unsigned loffE = (unsigned)(rin * K + ((chp ^ (rin >> 1)) << 3)) * 2u;
    const unsigned loffO = (unsigned)(rin * K + ((chp ^ (rin >> 1) ^ 4) << 3)) * 2u;
    const int fsw = lr >> 1;
    const int half = w >> 2;
#define GEMM_STAGE(ga_, gb_, kt_, buf_) do { \
        char* _d = lds + (buf_) * 49152; \
        const size_t _k = (size_t)(kt_) * 64; \
        unsigned _lE = loffE, _lO = loffO; asm volatile("" : "+v"(_lE), "+v"(_lO)); \
        _Pragma("unroll") for (int _i = 0; _i < 4; ++_i) { \
            const char* _b = (const char*)((ga_) + (size_t)(w * 32 + _i * 8) * K + _k); \
            __builtin_amdgcn_global_load_lds((const unsigned*)(_b + ((_i & 1) ? _lO : _lE)), (__attribute__((address_space(3))) unsigned*)(_d + w * 4096 + _i * 1024), 16, 0, 0); } \
        _Pragma("unroll") for (int _i = 0; _i < 2; ++_i) { \
            const char* _b = (const char*)((gb_) + (size_t)(w * 16 + _i * 8) * K + _k); \
            __builtin_amdgcn_global_load_lds((const unsigned*)(_b + ((_i & 1) ? _lO : _lE)), (__attribute__((address_space(3))) unsigned*)(_d + 32768 + w * 2048 + _i * 1024), 16, 0, 0); } \
    } while (0)
#define GEMM_PIECE(ga_, gb_, kt_, buf_, pc_) do { \
        char* _d = lds + (buf_) * 49152; \
        const size_t _k = (size_t)(kt_) * 64; \
        unsigned _l = ((pc_) & 1) ? loffO : loffE; asm volatile("" : "+v"(_l)); \
        if ((pc_) < 4) { const char* _b = (const char*)((ga_) + (size_t)(w * 32 + (pc_) * 8) * K + _k); \
            __builtin_amdgcn_global_load_lds((const unsigned*)(_b + _l), (__attribute__((address_space(3))) unsigned*)(_d + w * 4096 + (pc_) * 1024), 16, 0, 0); } \
        else { const char* _b = (const char*)((gb_) + (size_t)(w * 16 + ((pc_) - 4) * 8) * K + _k); \
            __builtin_amdgcn_global_load_lds((const unsigned*)(_b + _l), (__attribute__((address_space(3))) unsigned*)(_d + 32768 + w * 2048 + ((pc_) - 4) * 1024), 16, 0, 0); } \
    } while (0)
    int t = blockIdx.x;
    if (t >= ntiles) return;
    int cur = 0;
    {
        const bf16_t* ga = A + (size_t)((t & 31) * 256) * K;
        const bf16_t* gb = Bt + (size_t)((t >> 5) * 128) * K;
        __syncthreads();
        GEMM_STAGE(ga, gb, 0, 0);
        GEMM_STAGE(ga, gb, 1, 1);
    }
    bool first = true;
    for (; t < ntiles; t += gridDim.x) {
        const int pm = t & 31, pn = t >> 5;
        const int m0 = pm * 256, n0 = pn * 128;
        f32x4 acc[4][4];
#pragma unroll
        for (int i = 0; i < 4; ++i)
#pragma unroll
            for (int j = 0; j < 4; ++j) acc[i][j] = (f32x4){0.f, 0.f, 0.f, 0.f};
        const bf16_t* ga = A + (size_t)m0 * K;
        const bf16_t* gb = Bt + (size_t)n0 * K;
        const int tn = t + gridDim.x;
        const bool has_next = tn < ntiles;
        const bf16_t* ga2 = A + (size_t)((tn & 31) * 256) * K;
        const bf16_t* gb2 = Bt + (size_t)((tn >> 5) * 128) * K;
        bf16x8 af[2][4], bfr[2][4];
#define GEMM_READ() do { \
            _Pragma("unroll") for (int ks = 0; ks < 2; ++ks) { \
                const int coff = ((ks * 4 + g) ^ fsw) << 4; \
                _Pragma("unroll") for (int mt = 0; mt < 4; ++mt) af[ks][mt] = *(const bf16x8*)(sa + (wr * 64 + mt * 16 + lr) * 128 + coff); \
                _Pragma("unroll") for (int nt = 0; nt < 4; ++nt) bfr[ks][nt] = *(const bf16x8*)(sb + (wc * 64 + nt * 16 + lr) * 128 + coff); \
            } } while (0)
#define GEMM_MMA() do { \
            _Pragma("unroll") for (int ks = 0; ks < 2; ++ks) \
                _Pragma("unroll") for (int mt = 0; mt < 4; ++mt) \
                    _Pragma("unroll") for (int nt = 0; nt < 4; ++nt) acc[mt][nt] = MFMA16(bfr[ks][nt], af[ks][mt], acc[mt][nt]); \
            } while (0)
#define GEMM_MMA_DMA(kt_) do { \
            const int slot2 = (cur == 0) ? 2 : cur - 1; \
            const bool _own = (kt_) + 2 < nk; const bool _any = _own || has_next; \
            const bf16_t* _ga = _own ? ga : ga2; const bf16_t* _gb = _own ? gb : gb2; const int _kk = _own ? (kt_) + 2 : (kt_) + 2 - nk; \
            _Pragma("unroll") for (int ks = 0; ks < 2; ++ks) \
                _Pragma("unroll") for (int mt = 0; mt < 4; ++mt) { \
                    _Pragma("unroll") for (int nt = 0; nt < 4; ++nt) acc[mt][nt] = MFMA16(bfr[ks][nt], af[ks][mt], acc[mt][nt]); \
                    const int _g = ks * 4 + mt; \
                    if ((_g == 1 || _g == 3 || _g == 5) && _any) { __builtin_amdgcn_sched_barrier(0); GEMM_PIECE(_ga, _gb, _kk, slot2, (_g - 1) >> 1); __builtin_amdgcn_sched_barrier(0); } \
                } \
            } while (0)
#define GEMM_SLOT_A(kt_) do { \
            if ((kt_) == 0) { if (first) asm volatile("s_waitcnt vmcnt(6) lgkmcnt(0)" ::: "memory"); else asm volatile("s_waitcnt lgkmcnt(0)" ::: "memory"); } \
            else if ((kt_) + 1 < nk || has_next) asm volatile("s_waitcnt vmcnt(6) lgkmcnt(0)" ::: "memory"); \
            else asm volatile("s_waitcnt vmcnt(0) lgkmcnt(0)" ::: "memory"); \
            __builtin_amdgcn_sched_barrier(0); __builtin_amdgcn_s_barrier(); __builtin_amdgcn_sched_barrier(0); \
            asm volatile("" ::: "memory"); \
        } while (0)
#define GEMM_MID_BAR() do { \
            asm volatile("s_waitcnt lgkmcnt(0)" ::: "memory"); \
            __builtin_amdgcn_sched_barrier(0); __builtin_amdgcn_s_barrier(); __builtin_amdgcn_sched_barrier(0); \
            asm volatile("" ::: "memory"); \
        } while (0)
#define GEMM_REST(kt_) do { \
            asm volatile("s_waitcnt lgkmcnt(0)" ::: "memory"); \
            __builtin_amdgcn_sched_barrier(0); \
            const int slot2 = (cur == 0) ? 2 : cur - 1; \
            const bool _own = (kt_) + 2 < nk; \
            if (_own || has_next) { \
                const bf16_t* _ga = _own ? ga : ga2; const bf16_t* _gb = _own ? gb : gb2; const int _kk = _own ? (kt_) + 2 : (kt_) + 2 - nk; \
                GEMM_PIECE(_ga, _gb, _kk, slot2, 3); GEMM_PIECE(_ga, _gb, _kk, slot2, 4); GEMM_PIECE(_ga, _gb, _kk, slot2, 5); } \
            __builtin_amdgcn_sched_barrier(0); \
        } while (0)
        if (half == 0) {
            for (int kt = 0; kt < nk; ++kt) {
                GEMM_SLOT_A(kt);
                const char* sa = lds + cur * 49152;
                const char* sb = sa + 32768;
                GEMM_READ();
                GEMM_REST(kt);
                GEMM_MID_BAR();
                GEMM_MMA_DMA(kt);
                cur = (cur == 2) ? 0 : cur + 1;
            }
        } else {
            for (int kt = 0; kt < nk; ++kt) {
                GEMM_SLOT_A(kt);
                if (kt > 0) GEMM_MMA_DMA(kt);
                else { const int slot2 = (cur == 0) ? 2 : cur - 1; GEMM_PIECE(ga, gb, 2, slot2, 0); GEMM_PIECE(ga, gb, 2, slot2, 1); GEMM_PIECE(ga, gb, 2, slot2, 2); }
                GEMM_MID_BAR();
                const char* sa = lds + cur * 49152;
                const char* sb = sa + 32768;
                GEMM_READ();
                GEMM_REST(kt);
                cur = (cur == 2) ? 0 : cur + 1;
            }
            asm volatile("s_waitcnt lgkmcnt(0)" ::: "memory");
            GEMM_MMA();
        }
#undef GEMM_REST
#undef GEMM_SLOT_A
#undef GEMM_MID_BAR
        if (has_next) asm volatile("s_waitcnt vmcnt(6)" ::: "memory");
        first = false;
#undef GEMM_READ
#undef GEMM_MMA
#undef GEMM_MMA_DMA
        const int mbase = m0 + wr * 64 + lr;
        const int nbase = n0 + wc * 64 + g * 4;
        if (EPI == EPI_F32) {
            bf16_t* Y = (bf16_t*)(p.ws + OFF_Y);
#pragma unroll
            for (int mt = 0; mt < 4; ++mt)
#pragma unroll
                for (int np = 0; np < 2; ++np) {
                    const f32x4 v0 = acc[mt][2 * np], v1 = acc[mt][2 * np + 1];
                    u32x2 a, b; a[0] = pack2(v0[0], v0[1]); a[1] = pack2(v0[2], v0[3]); b[0] = pack2(v1[0], v1[1]); b[1] = pack2(v1[2], v1[3]);
                    store_pair16(Y + (size_t)(mbase + mt * 16) * N + n0 + wc * 64 + np * 32, a, b, g);
                }
        } else if (EPI == EPI_GU) {
            bf16_t* U = (bf16_t*)(p.ws + OFF_U);
#pragma unroll
            for (int mt = 0; mt < 4; ++mt) {
                u32x2 o[2];
#pragma unroll
                for (int nt = 0; nt < 2; ++nt) {
                    const f32x4 gt = acc[mt][nt], up = acc[mt][nt + 2];
                    o[nt][0] = pack2(silu_f(gt[0]) * up[0], silu_f(gt[1]) * up[1]);
                    o[nt][1] = pack2(silu_f(gt[2]) * up[2], silu_f(gt[3]) * up[3]);
                }
                store_pair16(U + (size_t)(mbase + mt * 16) * DFF + pn * 64 + wc * 32, o[0], o[1], g);
            }
        } else {
            const int ncol0 = n0 + wc * 64;
            int sec, cofs, pitch;
            if (EPI == EPI_QKV_DIFF) { sec = ncol0 >> 10; cofs = ncol0 & 1023; pitch = 1024; }
            else { sec = ncol0 < 1024 ? 0 : (ncol0 < 1280 ? 1 : 2); cofs = sec == 0 ? ncol0 : (sec == 1 ? ncol0 - 1024 : ncol0 - 1280); pitch = sec == 0 ? 1024 : 256; }
            const bool latent = m0 >= NPROMPT;
            if (latent && sec < 2) {
                const float* rt = (const float*)(p.ws + OFF_ROPE);
#pragma unroll
                for (int mt = 0; mt < 4; ++mt) {
                    const int tl = (mbase + mt * 16 - NPROMPT) & 2047;
                    const int prow = tl >> 6, pcol = tl & 63;
                    const f32x4 r0 = *(const f32x4*)(rt + (prow * 16 + g * 4) * 2), r1 = *(const f32x4*)(rt + (prow * 16 + g * 4) * 2 + 4);
                    const f32x4 c0 = *(const f32x4*)(rt + (pcol * 16 + g * 4) * 2), c1 = *(const f32x4*)(rt + (pcol * 16 + g * 4) * 2 + 4);
                    const float cr[4] = {r0[0], r0[2], r1[0], r1[2]}, sr[4] = {r0[1], r0[3], r1[1], r1[3]};
                    const float cc[4] = {c0[0], c0[2], c1[0], c1[2]}, sc[4] = {c0[1], c0[3], c1[1], c1[3]};
#pragma unroll
                    for (int r = 0; r < 4; ++r) {
                        const float x1 = acc[mt][0][r], x2 = acc[mt][1][r], x3 = acc[mt][2][r], x4 = acc[mt][3][r];
                        acc[mt][0][r] = x1 * cr[r] - x2 * sr[r];
                        acc[mt][1][r] = x2 * cr[r] + x1 * sr[r];
                        acc[mt][2][r] = x3 * cc[r] - x4 * sc[r];
                        acc[mt][3][r] = x4 * cc[r] + x3 * sc[r];
                    }
                }
            }
            bf16_t* dstb = (bf16_t*)(p.ws + (sec == 0 ? OFF_Q : (sec == 1 ? OFF_K : OFF_V)));
            float* dstf = nullptr;
            if (!latent && sec > 0) {
                if (EPI == EPI_QKV_DIFF) dstf = p.out + (sec == 1 ? OUT_NDK : OUT_NDV);
                else dstf = p.out + (sec == 1 ? OUT_NSK : OUT_NSV);
            }
#pragma unroll
            for (int mt = 0; mt < 4; ++mt) {
                u32x2 o[4];
#pragma unroll
                for (int nt = 0; nt < 4; ++nt) {
                    const size_t idx = (size_t)(mbase + mt * 16) * pitch + cofs + g * 4 + nt * 16;
                    const f32x4 v = acc[mt][nt];
                    const f32x4 vs = (sec == 0) ? v * SC : v;
                    o[nt][0] = pack2(vs[0], vs[1]); o[nt][1] = pack2(vs[2], vs[3]);
                    if (dstf) *(f32x4*)(dstf + idx) = v;
                }
                bf16_t* rowp = dstb + (size_t)(mbase + mt * 16) * pitch + cofs;
                store_pair16(rowp, o[0], o[1], g);
                store_pair16(rowp + 32, o[2], o[3], g);
            }
        }
    }
}

#undef GEMM_STAGE
template <bool DIFF>
__device__ void attn_phase(const Params& p, char* lds) {
    constexpr int DV = DIFF ? 128 : 64, MT = DV / 16;
    constexpr int KBYTES = DIFF ? 16384 : 8192, VPITCH = DV * 2 + 32, BUFB = KBYTES + 64 * VPITCH;
    constexpr int NCH = DIFF ? 2 : 1, KSTEP = DIFF ? 32 : 64, PITCH = DIFF ? 1024 : 256;
    static_assert(2 * BUFB <= LDS_MAIN, "lds");
    const int tid = threadIdx.x, lane = tid & 63, w = tid >> 6, sub = w & 1, qg = w >> 1, lr = lane & 15, g = lane >> 4;
    const bf16_t* qbuf = (const bf16_t*)(p.ws + OFF_Q);
    const bf16_t* kbuf = (const bf16_t*)(p.ws + OFF_K);
    const bf16_t* vbuf = (const bf16_t*)(p.ws + OFF_V);
    bf16_t* obuf = (bf16_t*)(p.ws + OFF_O);
    float lam = 0.f;
    if (DIFF) {
        const float* dl = p.diff_lambda;
        const float a = wave_sum(dl[lane] * dl[64 + lane]), b = wave_sum(dl[128 + lane] * dl[192 + lane]);
        lam = __expf(a) - __expf(b) + 0.2f;
    }
    const int skey = DIFF ? (tid >> 4) : (tid >> 3), sch = DIFF ? (tid & 15) : (tid & 7);
    const int k_st = DIFF ? ((sch >> 3) * 8192 + skey * 128 + (((sch & 7) ^ ((skey >> 1) & 7)) << 4)) : (skey * 128 + ((sch ^ ((skey >> 1) & 7)) << 4));
    const int v_st = KBYTES + skey * VPITCH + sch * 16;
    const int g_off = skey * PITCH + sch * 8;

    const bool bg_first = (__popc(blockIdx.x) & 1) != 0;
    if (DIFF && bg_first) deferred_transposes(p, lds);
    for (int u = blockIdx.x; u < 512; u += gridDim.x) {
        int qtok0, n0t, t_lo, t_hi, vhead, qpos0 = 0;
        bool band = false;
        const bf16_t *K0 = nullptr, *V0 = nullptr, *K1, *V1;
        float m_init = 0.f, l_init = 0.f;
        if (DIFF) {
            int b, h, qb;
            if (u < 256) {
                const int xcd = u & 7, slot = u >> 3, bh = xcd * 2 + (slot >> 4);
                qb = slot & 15; b = bh >> 3; h = bh & 7;
                qtok0 = NPROMPT + b * 2048 + qb * 128;
                K0 = (const bf16_t*)(p.ws + OFF_CKD) + (size_t)(b * 512) * 1024 + h * 128;
                V0 = (const bf16_t*)(p.ws + OFF_CVD) + (size_t)(b * 512) * 1024 + h * 128;
                n0t = 8;
                K1 = kbuf + (size_t)(NPROMPT + b * 2048) * 1024 + h * 128;
                V1 = vbuf + (size_t)(NPROMPT + b * 2048) * 1024 + h * 128;
                t_lo = 0; t_hi = 32;
            } else {
                const int v = u - 256;
                b = v >> 4; h = (v >> 1) & 7; qb = v & 1;
                qtok0 = b * 256 + qb * 128;
                n0t = 0;
                K1 = kbuf + (size_t)(b * 256) * 1024 + h * 128;
                V1 = vbuf + (size_t)(b * 256) * 1024 + h * 128;
                t_lo = 0; t_hi = 4;
            }
            vhead = h * 2 + sub;
        } else {
            int b, kv, hp, qb;
            if (u < 256) {
                const int xcd = u & 7, slot = u >> 3;
                b = xcd >> 2; kv = xcd & 3; hp = slot >> 4; qb = slot & 15;
                qtok0 = NPROMPT + b * 2048 + qb * 128;
                K0 = (const bf16_t*)(p.ws + OFF_CKS) + (size_t)(b * 512) * 256 + kv * 64;
                V0 = (const bf16_t*)(p.ws + OFF_CVS) + (size_t)(b * 512) * 256 + kv * 64;
                n0t = 8;
                K1 = kbuf + (size_t)(NPROMPT + b * 2048) * 256 + kv * 64;
                V1 = vbuf + (size_t)(NPROMPT + b * 2048) * 256 + kv * 64;
                t_lo = 2 * qb - 2 < 0 ? 0 : 2 * qb - 2; t_hi = 2 * qb + 4 > 32 ? 32 : 2 * qb + 4;
                band = true; qpos0 = qb * 128;
            } else {
                const int v = u - 256;
                b = v >> 4; kv = (v >> 2) & 3; hp = (v >> 1) & 1; qb = v & 1;
                qtok0 = b * 256 + qb * 128;
                n0t = 0;
                K1 = kbuf + (size_t)(b * 256) * 256 + kv * 64;
                V1 = vbuf + (size_t)(b * 256) * 256 + kv * 64;
                t_lo = 0; t_hi = 4;
            }
            vhead = kv * 4 + hp * 2 + sub;
            m_init = p.swa_sink[vhead] * LOG2E;
            l_init = (g == 0) ? 1.f : 0.f;
        }
        const int ntile = n0t + (t_hi - t_lo);
        bf16x8 qf[2][2];
#pragma unroll
        for (int nt = 0; nt < 2; ++nt)
#pragma unroll
            for (int ks = 0; ks < 2; ++ks)
                qf[nt][ks] = *(const bf16x8*)(qbuf + (size_t)(qtok0 + qg * 32 + nt * 16 + lr) * 1024 + vhead * 64 + ks * 32 + g * 8);
        f32x4 O[MT][2];
#pragma unroll
        for (int i = 0; i < MT; ++i) { O[i][0] = (f32x4){0.f, 0.f, 0.f, 0.f}; O[i][1] = (f32x4){0.f, 0.f, 0.f, 0.f}; }
        float mrun[2] = {m_init, m_init};
        f32x4 Lacc[2] = {(f32x4){l_init, 0.f, 0.f, 0.f}, (f32x4){l_init, 0.f, 0.f, 0.f}};
        const short one_bf = (lr == 0) ? (short)0x3F80 : (short)0;
        const bf16x8 vones = {one_bf, one_bf, one_bf, one_bf, one_bf, one_bf, one_bf, one_bf};

        u32x4 rk[NCH], rv[NCH];
        {
            const bf16_t* kp = (n0t > 0) ? K0 : K1 + (size_t)t_lo * 64 * PITCH;
            const bf16_t* vp = (n0t > 0) ? V0 : V1 + (size_t)t_lo * 64 * PITCH;
#pragma unroll
            for (int c = 0; c < NCH; ++c) { rk[c] = *(const u32x4*)(kp + g_off + c * KSTEP * PITCH); rv[c] = *(const u32x4*)(vp + g_off + c * KSTEP * PITCH); }
#pragma unroll
            for (int c = 0; c < NCH; ++c) { *(u32x4*)(lds + k_st + c * KSTEP * 128) = rk[c]; *(u32x4*)(lds + v_st + c * KSTEP * VPITCH) = rv[c]; }
        }
        __syncthreads();
        for (int i = 0; i < ntile; ++i) {
            const bool more = i + 1 < ntile;
            if (more) {
                const int j = i + 1;
                const bf16_t* kp = (j < n0t) ? K0 + (size_t)j * 64 * PITCH : K1 + (size_t)(t_lo + j - n0t) * 64 * PITCH;
                const bf16_t* vp = (j < n0t) ? V0 + (size_t)j * 64 * PITCH : V1 + (size_t)(t_lo + j - n0t) * 64 * PITCH;
#pragma unroll
                for (int c = 0; c < NCH; ++c) { rk[c] = *(const u32x4*)(kp + g_off + c * KSTEP * PITCH); rv[c] = *(const u32x4*)(vp + g_off + c * KSTEP * PITCH); }
            }
            __builtin_amdgcn_sched_barrier(0);
            const char* buf = lds + (i & 1) * BUFB;
            const char* kb = buf + (DIFF ? sub * 8192 : 0);
            const char* vb = buf + KBYTES;
            f32x4 S[4][2];
            const f32x4 cin0 = {-mrun[0], -mrun[0], -mrun[0], -mrun[0]}, cin1 = {-mrun[1], -mrun[1], -mrun[1], -mrun[1]};
#pragma unroll
            for (int kt = 0; kt < 4; ++kt) {
                const bf16x8 kf = *(const bf16x8*)(kb + (kt * 16 + lr) * 128 + ((g ^ (lr >> 1)) << 4));
                S[kt][0] = MFMA16(kf, qf[0][0], cin0);
                S[kt][1] = MFMA16(kf, qf[1][0], cin1);
            }
#pragma unroll
            for (int kt = 0; kt < 4; ++kt) {
                const bf16x8 kf = *(const bf16x8*)(kb + (kt * 16 + lr) * 128 + (((4 + g) ^ (lr >> 1)) << 4));
                S[kt][0] = MFMA16(kf, qf[0][1], S[kt][0]);
                S[kt][1] = MFMA16(kf, qf[1][1], S[kt][1]);
            }
            const bool domask = band && i >= n0t && (unsigned)((t_lo + i - n0t) - (qpos0 >> 6)) >= 2u;
            const int kpos0 = (t_lo + i - n0t) * 64 + g * 4;
#pragma unroll
            for (int nt = 0; nt < 2; ++nt) {
                const int qpos = qpos0 + qg * 32 + nt * 16 + lr;
                float mx = -3.0e38f;
                if (domask) {
                    const int d0 = qpos - kpos0;
                    if ((t_lo + i - n0t) < (qpos0 >> 6)) {
                        const int thr = d0 - 128;
#pragma unroll
                        for (int kt = 0; kt < 4; ++kt)
#pragma unroll
                            for (int r = 0; r < 4; ++r) if (kt * 16 + r < thr) S[kt][nt][r] = -1e30f;
                    } else {
                        const int thr = d0 + 128;
#pragma unroll
                        for (int kt = 0; kt < 4; ++kt)
#pragma unroll
                            for (int r = 0; r < 4; ++r) if (kt * 16 + r > thr) S[kt][nt][r] = -1e30f;
                    }
                }
#pragma unroll
                for (int kt = 0; kt < 4; ++kt)
#pragma unroll
                    for (int r = 0; r < 4; ++r) mx = fmaxf(mx, S[kt][nt][r]);
                if (__builtin_amdgcn_ballot_w64((mx > 8.f) || (DIFF && i == 0)) != 0ull) {
                    mx = rows_max(mx);
                    const bool raise = (mx > 8.f) || (DIFF && i == 0);
                    const float delta = raise ? fmaxf(mx, -100.f) : 0.f;
                    const float alpha = __builtin_amdgcn_exp2f(-delta);
                    mrun[nt] += delta;
                    Lacc[nt] = Lacc[nt] * alpha;
#pragma unroll
                    for (int mt = 0; mt < MT; ++mt) O[mt][nt] = O[mt][nt] * alpha;
#pragma unroll
                    for (int kt = 0; kt < 4; ++kt) S[kt][nt] = S[kt][nt] - delta;
                }
#pragma unroll
                for (int kt = 0; kt < 4; ++kt)
#pragma unroll
                    for (int r = 0; r < 4; ++r) S[kt][nt][r] = __builtin_amdgcn_exp2f(S[kt][nt][r]);
            }
#pragma unroll
            for (int ks2 = 0; ks2 < 2; ++ks2) {
                bf16x8 pf[2];
#pragma unroll
                for (int nt = 0; nt < 2; ++nt) {
                    u32x4 pk;
                    pk[0] = pack2(S[2 * ks2][nt][0], S[2 * ks2][nt][1]); pk[1] = pack2(S[2 * ks2][nt][2], S[2 * ks2][nt][3]);
                    pk[2] = pack2(S[2 * ks2 + 1][nt][0], S[2 * ks2 + 1][nt][1]); pk[3] = pack2(S[2 * ks2 + 1][nt][2], S[2 * ks2 + 1][nt][3]);
                    pf[nt] = __builtin_bit_cast(bf16x8, pk);
                    Lacc[nt] = MFMA16(vones, pf[nt], Lacc[nt]);
                }
                const char* vrow = vb + (ks2 * 32 + g * 4 + (lr >> 2)) * VPITCH + (lr & 3) * 8;
#pragma unroll
                for (int mt = 0; mt < MT; ++mt) {
                    const s16x4 v0 = __builtin_amdgcn_ds_read_tr16_b64_v4i16((s16x4 __attribute__((address_space(3)))*)(vrow + mt * 32));
                    const s16x4 v1 = __builtin_amdgcn_ds_read_tr16_b64_v4i16((s16x4 __attribute__((address_space(3)))*)(vrow + mt * 32 + 16 * VPITCH));
                    const bf16x8 vf = __builtin_shufflevector(v0, v1, 0, 1, 2, 3, 4, 5, 6, 7);
                    O[mt][0] = MFMA16(vf, pf[0], O[mt][0]);
                    O[mt][1] = MFMA16(vf, pf[1], O[mt][1]);
                }
            }
            if (more) {
                char* nb = lds + ((i + 1) & 1) * BUFB;
#pragma unroll
                for (int c = 0; c < NCH; ++c) { *(u32x4*)(nb + k_st + c * KSTEP * 128) = rk[c]; *(u32x4*)(nb + v_st + c * KSTEP * VPITCH) = rv[c]; }
            }
            __syncthreads();
        }
#pragma unroll
        for (int nt = 0; nt < 2; ++nt) {
            const float l = rows_sum(Lacc[nt][0]);
            const float inv = __builtin_amdgcn_rcpf(l);
#pragma unroll
            for (int mt = 0; mt < MT; ++mt) O[mt][nt] = O[mt][nt] * inv;
        }
        if (DIFF) {
            float* ex = (float*)lds;
            if (sub == 1) {
#pragma unroll
                for (int nt = 0; nt < 2; ++nt)
#pragma unroll
                    for (int mt = 0; mt < MT; ++mt)
#pragma unroll
                        for (int r = 0; r < 4; ++r) ex[((qg * 2 + nt) * 32 + mt * 4 + r) * 64 + lane] = O[mt][nt][r];
            }
            __syncthreads();
            if (sub == 0) {
                const float* gs = p.diff_subln_g;
                const int h = vhead >> 1;
#pragma unroll
                for (int nt = 0; nt < 2; ++nt) {
                    float ss = 0.f;
#pragma unroll
                    for (int mt = 0; mt < MT; ++mt)
#pragma unroll
                        for (int r = 0; r < 4; ++r) {
                            const float d = O[mt][nt][r] - lam * ex[((qg * 2 + nt) * 32 + mt * 4 + r) * 64 + lane];
                            O[mt][nt][r] = d;
                            ss += d * d;
                        }
                    ss = rows_sum(ss);
                    const float rstd = rsqrtf(ss * (1.f / 128.f) + EPS) * 0.8f;
                    bf16_t* orow = obuf + (size_t)(qtok0 + qg * 32 + nt * 16 + lr) * 1024 + h * 128;
#pragma unroll
                    for (int mp = 0; mp < MT / 2; ++mp) {
                        u32x2 o[2];
#pragma unroll
                        for (int e = 0; e < 2; ++e) {
                            const int mt = 2 * mp + e;
                            const f32x4 gg = *(const f32x4*)(gs + mt * 16 + g * 4);
                            const f32x4 v = O[mt][nt] * rstd * gg;
                            o[e][0] = pack2(v[0], v[1]); o[e][1] = pack2(v[2], v[3]);
                        }
                        store_pair16(orow + mp * 32, o[0], o[1], g);
                    }
                }
            }
            __syncthreads();
        } else {
#pragma unroll
            for (int nt = 0; nt < 2; ++nt) {
                bf16_t* orow = obuf + (size_t)(qtok0 + qg * 32 + nt * 16 + lr) * 1024 + vhead * 64;
#pragma unroll
                for (int mp = 0; mp < MT / 2; ++mp) {
                    const f32x4 v0 = O[2 * mp][nt], v1 = O[2 * mp + 1][nt];
                    u32x2 a, b; a[0] = pack2(v0[0], v0[1]); a[1] = pack2(v0[2], v0[3]); b[0] = pack2(v1[0], v1[1]); b[1] = pack2(v1[2], v1[3]);
                    store_pair16(orow + mp * 32, a, b, g);
                }
            }
        }
    }
    if (DIFF && !bg_first) deferred_transposes(p, lds);
}

__global__ void __launch_bounds__(512, 2) mega(Params p) {
    extern __shared__ __attribute__((aligned(16))) char lds[];
    cg::grid_group grid = cg::this_grid();
    if (p.ws == nullptr) grid.sync();
    volatile LAS unsigned* st = (volatile LAS unsigned*)(lds + LDS_MAIN);
    if (threadIdx.x == 0) { st[0] = 0u; st[1] = 0u; st[2] = 0u; st[3] = 0u; }
    __syncthreads();
    const XcdBarrier xb = xcd_barrier_post((unsigned*)(p.ws + OFF_BAR), st);
    const bf16_t* hbuf = (const bf16_t*)(p.ws + OFF_H);
    const bf16_t* obuf = (const bf16_t*)(p.ws + OFF_O);
    const bf16_t* ubuf = (const bf16_t*)(p.ws + OFF_U);
    prepass(p, lds);
    xcd_barrier(xb);
    rowphase<0>(p, 0);
    xcd_barrier(xb);
    gemm_phase<EPI_QKV_DIFF>(p, hbuf, (const bf16_t*)(p.ws + OFF_WQKV0), 3072, 1024, lds);
    xcd_barrier(xb);
    attn_phase<true>(p, lds);
    xcd_barrier(xb);
    gemm_phase<EPI_F32>(p, obuf, (const bf16_t*)(p.ws + OFF_WO0), 1024, 1024, lds);
    xcd_barrier(xb);
    rowphase<1>(p, 0);
    xcd_barrier(xb);
    gemm_phase<EPI_GU>(p, hbuf, (const bf16_t*)(p.ws + OFF_WGU0), 5632, 1024, lds);
    xcd_barrier(xb);
    gemm_phase<EPI_F32>(p, ubuf, (const bf16_t*)(p.ws + OFF_WD0), 1024, 2816, lds);
    xcd_barrier(xb);
    rowphase<2>(p, 0);
    xcd_barrier(xb);
    gemm_phase<EPI_QKV_SWA>(p, hbuf, (const bf16_t*)(p.ws + OFF_WQKV1), 1536, 1024, lds);
    xcd_barrier(xb);
    attn_phase<false>(p, lds);
    xcd_barrier(xb);
    gemm_phase<EPI_F32>(p, obuf, (const bf16_t*)(p.ws + OFF_WO1), 1024, 1024, lds);
    xcd_barrier(xb);
    rowphase<1>(p, 1);
    xcd_barrier(xb);
    gemm_phase<EPI_GU>(p, hbuf, (const bf16_t*)(p.ws + OFF_WGU1), 5632, 1024, lds);
    xcd_barrier(xb);
    gemm_phase<EPI_F32>(p, ubuf, (const bf16_t*)(p.ws + OFF_WD1), 1024, 2816, lds);
    xcd_barrier(xb);
    rowphase<2>(p, 1);
}

extern "C" void kernel_launch(void* const* d_in, const int* in_sizes, int n_in, void* d_out, int out_size, void* d_ws, size_t ws_size, hipStream_t stream) {
    static int grid_blocks = 0;
    if (grid_blocks == 0) {
        if (n_in != 21 || ws_size < WS_END) { fprintf(stderr, "kernel_launch: unexpected inputs (n_in %d, ws %zu < %zu)\n", n_in, ws_size, (size_t)WS_END); grid_blocks = -1; return; }
        int dev = 0, cus = 0, per_cu = 0;
        (void)hipGetDevice(&dev);
        (void)hipDeviceGetAttribute(&cus, hipDeviceAttributeMultiprocessorCount, dev);
        if (hipFuncSetAttribute((const void*)mega, hipFuncAttributeMaxDynamicSharedMemorySize, LDS_BYTES) != hipSuccess) { fprintf(stderr, "kernel_launch: hipFuncSetAttribute failed\n"); grid_blocks = -1; return; }
        if (hipOccupancyMaxActiveBlocksPerMultiprocessor(&per_cu, (const void*)mega, NTHR, LDS_BYTES) != hipSuccess || per_cu < 1) { fprintf(stderr, "kernel_launch: occupancy query failed (%d)\n", per_cu); grid_blocks = -1; return; }
        if (per_cu > 1) per_cu = 1;
        grid_blocks = cus * per_cu;
        fprintf(stderr, "kernel_launch: %d CUs x %d = %d workgroups\n", cus, per_cu, grid_blocks);
    }
    if (grid_blocks < 0) return;
    if (hipMemsetAsync((char*)d_ws + OFF_BAR, 0, XCD_BAR_WORDS * 4, stream) != hipSuccess) { fprintf(stderr, "kernel_launch: memset failed\n"); return; }
    Params p{};
    const float** pp = (const float**)&p;
    for (int i = 0; i < 21; ++i) pp[i] = (const float*)d_in[i];
    p.out = (float*)d_out;
    p.ws = (char*)d_ws;
    void* args[] = {&p};
    hipError_t e = hipLaunchCooperativeKernel((const void*)mega, dim3(grid_blocks), dim3(NTHR), args, LDS_BYTES, stream);
    if (e != hipSuccess) fprintf(stderr, "cooperative launch failed: %s (grid %d)\n", hipGetErrorString(e), grid_blocks);
}
```

```cpp
#include <hip/hip_runtime.h>
#include <hip/hip_cooperative_groups.h>
#include <cstdint>
#include <cstdio>
namespace cg = cooperative_groups;

typedef unsigned short bf16_t;
typedef short bf16x8 __attribute__((ext_vector_type(8)));
typedef short s16x4 __attribute__((ext_vector_type(4)));
typedef float f32x4 __attribute__((ext_vector_type(4)));
typedef float f32x2 __attribute__((ext_vector_type(2)));
typedef unsigned u32x4 __attribute__((ext_vector_type(4)));
typedef unsigned u32x2 __attribute__((ext_vector_type(2)));
typedef __bf16 bf2_t __attribute__((ext_vector_type(2)));
#define DI __device__ __forceinline__
#define MFMA16(a, b, c) __builtin_amdgcn_mfma_f32_16x16x32_bf16((a), (b), (c), 0, 0, 0)

constexpr int D = 1024, NTOK = 8192, NPROMPT = 4096, DFF = 2816;
constexpr float EPS = 1e-6f, LOG2E = 1.4426950408889634f, SC = 0.125f * 1.4426950408889634f;

constexpr size_t OFF_MOD = 0;
constexpr size_t OFF_ROPE = 147456;
constexpr size_t OFF_BAR = 163840;
constexpr size_t OFF_WQKV0 = 1u << 20;
constexpr size_t OFF_WO0 = OFF_WQKV0 + 3072ull * 1024 * 2;
constexpr size_t OFF_WGU0 = OFF_WO0 + 1024ull * 1024 * 2;
constexpr size_t OFF_WD0 = OFF_WGU0 + 5632ull * 1024 * 2;
constexpr size_t OFF_WQKV1 = OFF_WD0 + 1024ull * 2816 * 2;
constexpr size_t OFF_WO1 = OFF_WQKV1 + 1536ull * 1024 * 2;
constexpr size_t OFF_WGU1 = OFF_WO1 + 1024ull * 1024 * 2;
constexpr size_t OFF_WD1 = OFF_WGU1 + 5632ull * 1024 * 2;
constexpr size_t OFF_CKD = OFF_WD1 + 1024ull * 2816 * 2;
constexpr size_t OFF_CVD = OFF_CKD + 1024ull * 1024 * 2;
constexpr size_t OFF_CKS = OFF_CVD + 1024ull * 1024 * 2;
constexpr size_t OFF_CVS = OFF_CKS + 1024ull * 256 * 2;
constexpr size_t OFF_H = OFF_CVS + 1024ull * 256 * 2;
constexpr size_t OFF_Q = OFF_H + 8192ull * 1024 * 2;
constexpr size_t OFF_K = OFF_Q + 8192ull * 1024 * 2;
constexpr size_t OFF_V = OFF_K + 8192ull * 1024 * 2;
constexpr size_t OFF_U = OFF_Q;
constexpr size_t OFF_O = OFF_V + 8192ull * 1024 * 2;
constexpr size_t OFF_Y = OFF_O + 8192ull * 1024 * 2;
constexpr size_t OFF_X = OFF_Y + 8192ull * 1024 * 4;
constexpr size_t WS_END = OFF_X + 8192ull * 1024 * 4;
static_assert(8192ull * 2816 * 2 <= 3 * 8192ull * 1024 * 2, "U overlay");

constexpr size_t OUT_Y = 0, OUT_NDK = 8388608, OUT_NDV = 12582912, OUT_NSK = 16777216, OUT_NSV = 17825792;

constexpr int NTHR = 512, NWAVE = 8;
constexpr int LDS_MAIN = 147456, LDS_BYTES = LDS_MAIN + 16;

struct Params {
    const float *x_prompt, *x_sample, *cdk, *cdv, *csk, *csv, *c, *c_ctx, *w_mod, *b_mod, *norm_g, *w_qkv_diff, *diff_lambda, *diff_subln_g,
        *w_o_diff, *w_qkv_swa, *swa_sink, *w_o_swa, *w_gate, *w_up, *w_down;
    float* out;
    char* ws;
};

DI unsigned pack2(float a, float b) { bf2_t v; v[0] = (__bf16)a; v[1] = (__bf16)b; return __builtin_bit_cast(unsigned, v); }
DI float wave_sum(float v) {
#pragma unroll
    for (int o = 32; o > 0; o >>= 1) v += __shfl_xor(v, o);
    return v;
}
DI float rows_max(float v) {
    auto a = __builtin_amdgcn_permlane16_swap(__float_as_uint(v), __float_as_uint(v), false, false);
    v = fmaxf(__uint_as_float(a[0]), __uint_as_float(a[1]));
    auto b = __builtin_amdgcn_permlane32_swap(__float_as_uint(v), __float_as_uint(v), false, false);
    return fmaxf(__uint_as_float(b[0]), __uint_as_float(b[1]));
}
DI float rows_sum(float v) {
    auto a = __builtin_amdgcn_permlane16_swap(__float_as_uint(v), __float_as_uint(v), false, false);
    v = __uint_as_float(a[0]) + __uint_as_float(a[1]);
    auto b = __builtin_amdgcn_permlane32_swap(__float_as_uint(v), __float_as_uint(v), false, false);
    return __uint_as_float(b[0]) + __uint_as_float(b[1]);
}
DI float silu_f(float x) { return x * __builtin_amdgcn_rcpf(1.f + __expf(-x)); }


#define XB_TMO      128
#define XB_XCNT(j)  (256  + 64 * (j))
#define XB_XSUB(j)  (1280 + 64 * (j))
#define XB_XGEN(j)  (2304 + 64 * (j))
#define XB_TOP      3328
#define XB_TOPGEN   3392
#define XCD_BAR_WORDS 3456
#define XB_SPIN_CAP (1u << 18)
#define LAS __attribute__((address_space(3)))
DI unsigned xb_ld(unsigned* p) { return __hip_atomic_load(p, __ATOMIC_RELAXED, __HIP_MEMORY_SCOPE_AGENT); }
DI unsigned xb_add(unsigned* p, unsigned v) { return __hip_atomic_fetch_add(p, v, __ATOMIC_RELAXED, __HIP_MEMORY_SCOPE_AGENT); }
DI unsigned xb_xcc_id() { return (unsigned)__builtin_amdgcn_s_getreg((3 << 11) | 20) & 0xFu; }
#define XB_SPIN(cond, bar) do { unsigned _sp = 0; while (cond) { __builtin_amdgcn_s_sleep(1); \
    if ((++_sp & 255u) == 0u) { if (xb_ld(&(bar)[XB_TMO])) break; if (_sp > XB_SPIN_CAP) { atomicAdd(&(bar)[XB_TMO], 1u); break; } } } } while (0)
struct XcdBarrier { unsigned* bar; unsigned x; volatile LAS unsigned* st; };
DI XcdBarrier xcd_barrier_post(unsigned* bar, volatile LAS unsigned* st) {
    XcdBarrier b; b.bar = bar; b.x = xb_xcc_id(); b.st = st;
    if (threadIdx.x == 0) (void)xb_add(&bar[XB_XCNT(b.x)], 1u);
    return b;
}
DI void xcd_barrier_complete(unsigned* bar, unsigned x, unsigned& nloc, unsigned& nx) {
    const unsigned G = gridDim.x * gridDim.y * gridDim.z;
    unsigned sum, cnt, mine, sp = 0u;
    for (;;) {
        sum = 0u; cnt = 0u; mine = 0u;
#pragma unroll
        for (unsigned j = 0; j < 16; ++j) { const unsigned c = xb_ld(&bar[XB_XCNT(j)]); sum += c; cnt += (c > 0u) ? 1u : 0u; mine = (j == x) ? c : mine; }
        if (sum == G) break;
        __builtin_amdgcn_s_sleep(1);
        if ((++sp & 255u) == 0u) { if (xb_ld(&bar[XB_TMO])) break; if (sp > XB_SPIN_CAP) { atomicAdd(&bar[XB_TMO], 1u); break; } }
    }
    nloc = mine > 0u ? mine : 1u; nx = cnt > 0u ? cnt : 1u;
}
DI void xcd_barrier(const XcdBarrier& b) {
    asm volatile("s_waitcnt vmcnt(0)" ::: "memory");
    __syncthreads();
    if (threadIdx.x == 0) {
        unsigned* bar = b.bar;
        __builtin_amdgcn_s_waitcnt(0);
        unsigned nloc = b.st[0], nx = b.st[1];
        if (nloc == 0u) { xcd_barrier_complete(bar, b.x, nloc, nx); b.st[0] = nloc; b.st[1] = nx; }
        const unsigned old = xb_add(&bar[XB_XSUB(b.x)], 1u);
        const unsigned gen = old / nloc;
        if (old + 1u == (gen + 1u) * nloc) {
            __builtin_amdgcn_fence(__ATOMIC_RELEASE, "agent");
            asm volatile("s_waitcnt vmcnt(0)" ::: "memory");
            const unsigned og = xb_add(&bar[XB_TOP], 1u);
            const unsigned tg = og / nx;
            if (og + 1u == (tg + 1u) * nx) xb_add(&bar[XB_TOPGEN], 1u);
            else XB_SPIN(xb_ld(&bar[XB_TOPGEN]) == tg, bar);
            __builtin_amdgcn_fence(__ATOMIC_ACQUIRE, "agent");
            xb_add(&bar[XB_XGEN(b.x)], 1u);
            asm volatile("s_waitcnt vmcnt(0)" ::: "memory");
        } else {
            XB_SPIN(xb_ld(&bar[XB_XGEN(b.x)]) == gen, bar);
            __builtin_amdgcn_fence(__ATOMIC_ACQUIRE, "agent");
            asm volatile("s_waitcnt vmcnt(0)" ::: "memory");
        }
    }
    __syncthreads();
}

DI void transpose_item_wave(const float* __restrict__ src, int ld, int k0, int c0, bf16_t* __restrict__ dst, int K, int nrow0, float* scr, int lane) {
#pragma unroll 8
    for (int i = 0; i < 32; ++i) { const int kk = 2 * i + (lane >> 5); scr[kk * 33 + (lane & 31)] = src[(size_t)(k0 + kk) * ld + c0 + (lane & 31)]; }
    asm volatile("s_waitcnt lgkmcnt(0)" ::: "memory");
    const int c = lane & 7;
#pragma unroll
    for (int j = 0; j < 4; ++j) {
        const int n = (lane >> 3) + 8 * j;
        const float* r = scr + (8 * c) * 33 + n;
        u32x4 o;
        o[0] = pack2(r[0 * 33], r[1 * 33]); o[1] = pack2(r[2 * 33], r[3 * 33]); o[2] = pack2(r[4 * 33], r[5 * 33]); o[3] = pack2(r[6 * 33], r[7 * 33]);
        *(u32x4*)(dst + (size_t)(nrow0 + n) * K + k0 + 8 * c) = o;
    }
    asm volatile("s_waitcnt lgkmcnt(0)" ::: "memory");
}

DI void tr_block_item(const Params& p, int bi, char* lds) {
    const int tid = threadIdx.x;
    int ti = bi * NWAVE + (tid >> 6);
    const int l = ti >= 6272 ? 1 : 0; ti -= l * 6272;
    const int nq = l ? 1536 : 3072, i_qkv = 16 * (nq / 32);
    const float* src; const float* src2 = nullptr; int ld, K; bf16_t* dst; bool gu = false;
    if (ti < i_qkv) { src = l ? p.w_qkv_swa : p.w_qkv_diff; ld = nq; K = 1024; dst = (bf16_t*)(p.ws + (l ? OFF_WQKV1 : OFF_WQKV0)); }
    else if ((ti -= i_qkv) < 512) { src = l ? p.w_o_swa : p.w_o_diff; ld = 1024; K = 1024; dst = (bf16_t*)(p.ws + (l ? OFF_WO1 : OFF_WO0)); }
    else if ((ti -= 512) < 2816) { src = p.w_gate + (size_t)l * 1024 * 2816; src2 = p.w_up + (size_t)l * 1024 * 2816; ld = 2816; K = 1024; dst = (bf16_t*)(p.ws + (l ? OFF_WGU1 : OFF_WGU0)); gu = true; }
    else { ti -= 2816; src = p.w_down + (size_t)l * 2816 * 1024; ld = 1024; K = 2816; dst = (bf16_t*)(p.ws + (l ? OFF_WD1 : OFF_WD0)); }
    const int nkb = K / 64, kb = ti % nkb, nb = ti / nkb;
    int c0 = nb * 32;
    if (gu) { const int tile = nb >> 2, wc = (nb >> 1) & 1, isup = nb & 1; c0 = tile * 64 + wc * 32; if (isup) src = src2; }
    transpose_item_wave(src, ld, kb * 64, c0, dst, K, nb * 32, (float*)lds + (tid >> 6) * (64 * 33), tid & 63);
}
constexpr int TR_P0 = 192, TR_ALL = 1472;
__device__ void deferred_transposes(const Params& p, char* lds) {
    __syncthreads();
    for (int bi = TR_P0 + blockIdx.x; bi < TR_ALL; bi += gridDim.x) tr_block_item(p, bi, lds);
    __syncthreads();
}

__device__ void prepass(const Params& p, char* lds) {
    const int tid = threadIdx.x;
    constexpr int N_MOD = 192, N_ROPE = 2, N_TR = TR_P0, N_CACHE = 640;
    constexpr int TOTAL = N_MOD + N_ROPE + N_TR + N_CACHE;
    for (int it = blockIdx.x; it < TOTAL; it += gridDim.x) {
        if (it < N_MOD) {
            const int l = it / 96, n0 = (it % 96) * 64;
            float* sc = (float*)lds;
            float* red = sc + 3 * 1024;
            for (int e = tid; e < 3 * 1024; e += NTHR) {
                const int c = e >> 10, k = e & 1023;
                const float v = (c == 0) ? p.c_ctx[k] : p.c[(c - 1) * 1024 + k];
                sc[e] = silu_f(v);
            }
            __syncthreads();
            const int c4 = tid & 15, kg = tid >> 4;
            const float* w = p.w_mod + (size_t)l * 1024 * 6144 + (size_t)(kg * 32) * 6144 + n0 + c4 * 4;
            f32x4 a0 = {0.f, 0.f, 0.f, 0.f}, a1 = a0, a2 = a0;
#pragma unroll 8
            for (int k = 0; k < 32; ++k) {
                const f32x4 wv = *(const f32x4*)(w + (size_t)k * 6144);
                a0 += wv * sc[kg * 32 + k]; a1 += wv * sc[1024 + kg * 32 + k]; a2 += wv * sc[2048 + kg * 32 + k];
            }
            *(f32x4*)(red + (kg * 3 + 0) * 64 + c4 * 4) = a0; *(f32x4*)(red + (kg * 3 + 1) * 64 + c4 * 4) = a1; *(f32x4*)(red + (kg * 3 + 2) * 64 + c4 * 4) = a2;
            __syncthreads();
            if (tid < 192) {
                const int c = tid >> 6, cc = tid & 63;
                float s = p.b_mod[l * 6144 + n0 + cc];
#pragma unroll
                for (int q = 0; q < 32; ++q) s += red[(q * 3 + c) * 64 + cc];
                ((float*)(p.ws + OFF_MOD))[(l * 3 + c) * 6144 + n0 + cc] = s;
            }
            __syncthreads();
        } else if (it < N_MOD + N_ROPE) {
            float* rt = (float*)(p.ws + OFF_ROPE);
            const int e = (it - N_MOD) * NTHR + tid;
            const int pos = e >> 4, i = e & 15;
            const float inv = (float)exp2(-((double)i / 16.0) * 13.287712379549449);
            const float ang = (float)pos * inv;
            rt[e * 2] = (float)cos((double)ang);
            rt[e * 2 + 1] = (float)sin((double)ang);
        } else if (it < N_MOD + N_ROPE + N_TR) {
            tr_block_item(p, it - (N_MOD + N_ROPE), lds);
        } else {
            int ci = it - (N_MOD + N_ROPE + N_TR);
            const float* src; bf16_t* dst;
            if (ci < 256) { src = p.cdk; dst = (bf16_t*)(p.ws + OFF_CKD); }
            else if (ci < 512) { src = p.cdv; dst = (bf16_t*)(p.ws + OFF_CVD); ci -= 256; }
            else if (ci < 576) { src = p.csk; dst = (bf16_t*)(p.ws + OFF_CKS); ci -= 512; }
            else { src = p.csv; dst = (bf16_t*)(p.ws + OFF_CVS); ci -= 576; }
            const size_t e = (size_t)ci * 4096 + tid * 8;
            const f32x4 a = *(const f32x4*)(src + e), b = *(const f32x4*)(src + e + 4);
            u32x4 o; o[0] = pack2(a[0], a[1]); o[1] = pack2(a[2], a[3]); o[2] = pack2(b[0], b[1]); o[3] = pack2(b[2], b[3]);
            *(u32x4*)(dst + e) = o;
        }
    }
}

DI void bf8_to_f32(const u32x4 r, f32x4& a, f32x4& b) {
    a = (f32x4){__uint_as_float(r[0] << 16), __uint_as_float(r[0] & 0xffff0000u), __uint_as_float(r[1] << 16), __uint_as_float(r[1] & 0xffff0000u)};
    b = (f32x4){__uint_as_float(r[2] << 16), __uint_as_float(r[2] & 0xffff0000u), __uint_as_float(r[3] << 16), __uint_as_float(r[3] & 0xffff0000u)};
}
DI u32x4 f32_to_bf8(const f32x4 a, const f32x4 b) { u32x4 o; o[0] = pack2(a[0], a[1]); o[1] = pack2(a[2], a[3]); o[2] = pack2(b[0], b[1]); o[3] = pack2(b[2], b[3]); return o; }

template <int MODE>
__device__ void rowphase(const Params& p, int layer) {
    const int lane = threadIdx.x & 63, w = threadIdx.x >> 6;
    const float* mod = (const float*)(p.ws + OFF_MOD);
    bf16_t* xbuf = (bf16_t*)(p.ws + OFF_X);
    const bf16_t* ybuf = (const bf16_t*)(p.ws + OFF_Y);
    bf16_t* hbuf = (bf16_t*)(p.ws + OFF_H);
    constexpr int RB = 4;
    const bool last = (MODE == 2 && layer == 1);
    for (int rb = blockIdx.x * NWAVE + w; rb < NTOK / RB; rb += gridDim.x * NWAVE) {
        const int rowb = rb * RB;
        const int cond = rowb < NPROMPT ? 0 : 1 + ((rowb - NPROMPT) >> 11);
        const float* mrow = mod + (size_t)(layer * 3 + cond) * 6144;
        const int nl = (MODE == 2) ? layer + 1 : layer;
        const float* mrow2 = mod + (size_t)(nl * 3 + cond) * 6144;
        f32x4 vgpost[4], vgate[4], vgpre[4], vshift[4], vscale[4];
#pragma unroll
        for (int q = 0; q < 4; ++q) {
            const int o = (q >> 1) * 512 + lane * 8 + (q & 1) * 4;
            if (MODE != 0) {
                vgpost[q] = *(const f32x4*)(p.norm_g + (size_t)(layer * 4 + (MODE == 1 ? 1 : 3)) * D + o);
                vgate[q] = *(const f32x4*)(mrow + (MODE == 1 ? 2 : 5) * D + o);
            }
            if (!last) {
                vgpre[q] = *(const f32x4*)(p.norm_g + (size_t)(nl * 4 + (MODE == 1 ? 2 : 0)) * D + o);
                vshift[q] = *(const f32x4*)(mrow2 + (MODE == 1 ? 3 : 0) * D + o);
                vscale[q] = *(const f32x4*)(mrow2 + (MODE == 1 ? 4 : 1) * D + o) + 1.f;
            }
        }
#pragma unroll 2
        for (int j = 0; j < RB; ++j) {
            const int row = rowb + j;
            f32x4 x[4];
            if (MODE == 2 || layer == 1) {
#pragma unroll
                for (int i = 0; i < 2; ++i) bf8_to_f32(*(const u32x4*)(xbuf + (size_t)row * D + i * 512 + lane * 8), x[2 * i], x[2 * i + 1]);
            } else {
                const float* xin = row < NPROMPT ? p.x_prompt + (size_t)row * D : p.x_sample + (size_t)(row - NPROMPT) * D;
#pragma unroll
                for (int q = 0; q < 4; ++q) x[q] = *(const f32x4*)(xin + (q >> 1) * 512 + lane * 8 + (q & 1) * 4);
            }
            if (MODE != 0) {
                f32x4 y[4];
                float ss = 0.f;
#pragma unroll
                for (int i = 0; i < 2; ++i) bf8_to_f32(*(const u32x4*)(ybuf + (size_t)row * D + i * 512 + lane * 8), y[2 * i], y[2 * i + 1]);
#pragma unroll
                for (int q = 0; q < 4; ++q) ss += y[q][0] * y[q][0] + y[q][1] * y[q][1] + y[q][2] * y[q][2] + y[q][3] * y[q][3];
                ss = wave_sum(ss);
                const float rstd = rsqrtf(ss * (1.f / D) + EPS);
#pragma unroll
                for (int q = 0; q < 4; ++q) x[q] = x[q] + vgate[q] * (y[q] * rstd * vgpost[q]);
#pragma unroll
                for (int i = 0; i < 2; ++i) {
                    if (last) {
                        *(f32x4*)(p.out + OUT_Y + (size_t)row * D + i * 512 + lane * 8) = x[2 * i];
                        *(f32x4*)(p.out + OUT_Y + (size_t)row * D + i * 512 + lane * 8 + 4) = x[2 * i + 1];
                    } else *(u32x4*)(xbuf + (size_t)row * D + i * 512 + lane * 8) = f32_to_bf8(x[2 * i], x[2 * i + 1]);
                }
            }
            if (last) continue;
            float ss = 0.f;
#pragma unroll
            for (int q = 0; q < 4; ++q) ss += x[q][0] * x[q][0] + x[q][1] * x[q][1] + x[q][2] * x[q][2] + x[q][3] * x[q][3];
            ss = wave_sum(ss);
            const float rstd = rsqrtf(ss * (1.f / D) + EPS);
#pragma unroll
            for (int i = 0; i < 2; ++i) {
                const f32x4 h0 = (x[2 * i] * rstd * vgpre[2 * i]) * vscale[2 * i] + vshift[2 * i];
                const f32x4 h1 = (x[2 * i + 1] * rstd * vgpre[2 * i + 1]) * vscale[2 * i + 1] + vshift[2 * i + 1];
                *(u32x4*)(hbuf + (size_t)row * D + i * 512 + lane * 8) = f32_to_bf8(h0, h1);
            }
        }
    }
}

DI void store_pair16(bf16_t* rowp, u32x2 A, u32x2 B, int g) {
    auto r0 = __builtin_amdgcn_permlane16_swap(A[0], B[0], false, false);
    auto r1 = __builtin_amdgcn_permlane16_swap(A[1], B[1], false, false);
    u32x4 o; o[0] = r0[0]; o[1] = r1[0]; o[2] = r0[1]; o[3] = r1[1];
    *(u32x4*)(rowp + ((g & 1) ? 16 + (g - 1) * 4 : g * 4)) = o;
}
enum { EPI_F32 = 0, EPI_QKV_DIFF = 1, EPI_QKV_SWA = 2, EPI_GU = 3 };

template <int EPI>
__device__ void gemm_phase(const Params& p, const bf16_t* __restrict__ A, const bf16_t* __restrict__ Bt, const int N, const int K, char* lds) {
    const int tid = threadIdx.x, lane = tid & 63, w = __builtin_amdgcn_readfirstlane(tid >> 6), wr = w >> 1, wc = w & 1, lr = lane & 15, g = lane >> 4;
    const int nN = N >> 7, ntiles = 32 * nN, nk = K >> 6;
    const int rin = lane >> 3, chp = lane & 7;
    const unsigned loffE = (unsigned)(rin * K + ((chp ^ (rin >> 1)) << 3)) * 2u;
    const unsigned loffO = (unsigned)(rin * K + ((chp ^ (rin >> 1) ^ 4) << 3)) * 2u;
    const int fsw = lr >> 1;
    const int half = w >> 2;
#define GEMM_STAGE(ga_, gb_, kt_, buf_) do { \
        char* _d = lds + (buf_) * 49152; \
        const size_t _k = (size_t)(kt_) * 64; \
        unsigned _lE = loffE, _lO = loffO; asm volatile("" : "+v"(_lE), "+v"(_lO)); \
        _Pragma("unroll") for (int _i = 0; _i < 4; ++_i) { \
            const char* _b = (const char*)((ga_) + (size_t)(w * 32 + _i * 8) * K + _k); \
            __builtin_amdgcn_global_load_lds((const unsigned*)(_b + ((_i & 1) ? _lO : _lE)), (__attribute__((address_space(3))) unsigned*)(_d + w * 4096 + _i * 1024), 16, 0, 0); } \
        _Pragma("unroll") for (int _i = 0; _i < 2; ++_i) { \
            const char* _b = (const char*)((gb_) + (size_t)(w * 16 + _i * 8) * K + _k); \
            __builtin_amdgcn_global_load_lds((const unsigned*)(_b + ((_i & 1) ? _lO : _lE)), (__attribute__((address_space(3))) unsigned*)(_d + 32768 + w * 2048 + _i * 1024), 16, 0, 0); } \
    } while (0)
#define GEMM_PIECE(ga_, gb_, kt_, buf_, pc_) do { \
        char* _d = lds + (buf_) * 49152; \
        const size_t _k = (size_t)(kt_) * 64; \
        unsigned _l = ((pc_) & 1) ? loffO : loffE; asm volatile("" : "+v"(_l)); \
        if ((pc_) < 4) { const char* _b = (const char*)((ga_) + (size_t)(w * 32 + (pc_) * 8) * K + _k); \
            __builtin_amdgcn_global_load_lds((const unsigned*)(_b + _l), (__attribute__((address_space(3))) unsigned*)(_d + w * 4096 + (pc_) * 1024), 16, 0, 0); } \
        else { const char* _b = (const char*)((gb_) + (size_t)(w * 16 + ((pc_) - 4) * 8) * K + _k); \
            __builtin_amdgcn_global_load_lds((const unsigned*)(_b + _l), (__attribute__((address_space(3))) unsigned*)(_d + 32768 + w * 2048 + ((pc_) - 4) * 1024), 16, 0, 0); } \
    } while (0)
    int t = blockIdx.x;
    if (t >= ntiles) return;
    int cur = 0;
    {
        const bf16_t* ga = A + (size_t)((t & 31) * 256) * K;
        const bf16_t* gb = Bt + (size_t)((t >> 5) * 128) * K;
        __syncthreads();
        GEMM_STAGE(ga, gb, 0, 0);
        GEMM_STAGE(ga, gb, 1, 1);
    }
    bool first = true;
    for (; t < ntiles; t += gridDim.x) {
        const int pm = t & 31, pn = t >> 5;
        const int m0 = pm * 256, n0 = pn * 128;
        f32x4 acc[4][4];
#pragma unroll
        for (int i = 0; i < 4; ++i)
#pragma unroll
            for (int j = 0; j < 4; ++j) acc[i][j] = (f32x4){0.f, 0.f, 0.f, 0.f};
        const bf16_t* ga = A + (size_t)m0 * K;
        const bf16_t* gb = Bt + (size_t)n0 * K;
        const int tn = t + gridDim.x;
        const bool has_next = tn < ntiles;
        const bf16_t* ga2 = A + (size_t)((tn & 31) * 256) * K;
        const bf16_t* gb2 = Bt + (size_t)((tn >> 5) * 128) * K;
        bf16x8 af[2][4], bfr[2][4];
#define GEMM_READ() do { \
            _Pragma("unroll") for (int ks = 0; ks < 2; ++ks) { \
                const int coff = ((ks * 4 + g) ^ fsw) << 4; \
                _Pragma("unroll") for (int mt = 0; mt < 4; ++mt) af[ks][mt] = *(const bf16x8*)(sa + (wr * 64 + mt * 16 + lr) * 128 + coff); \
                _Pragma("unroll") for (int nt = 0; nt < 4; ++nt) bfr[ks][nt] = *(const bf16x8*)(sb + (wc * 64 + nt * 16 + lr) * 128 + coff); \
            } } while (0)
#define GEMM_MMA() do { \
            _Pragma("unroll") for (int ks = 0; ks < 2; ++ks) \
                _Pragma("unroll") for (int mt = 0; mt < 4; ++mt) \
                    _Pragma("unroll") for (int nt = 0; nt < 4; ++nt) acc[mt][nt] = MFMA16(bfr[ks][nt], af[ks][mt], acc[mt][nt]); \
            } while (0)
#define GEMM_MMA_DMA(kt_) do { \
            const int slot2 = (cur == 0) ? 2 : cur - 1; \
            const bool _own = (kt_) + 2 < nk; const bool _any = _own || has_next; \
            const bf16_t* _ga = _own ? ga : ga2; const bf16_t* _gb = _own ? gb : gb2; const int _kk = _own ? (kt_) + 2 : (kt_) + 2 - nk; \
            _Pragma("unroll") for (int ks = 0; ks < 2; ++ks) \
                _Pragma("unroll") for (int mt = 0; mt < 4; ++mt) { \
                    _Pragma("unroll") for (int nt = 0; nt < 4; ++nt) acc[mt][nt] = MFMA16(bfr[ks][nt], af[ks][mt], acc[mt][nt]); \
                    const int _g = ks * 4 + mt; \
                    if ((_g == 1 || _g == 3 || _g == 5) && _any) { __builtin_amdgcn_sched_barrier(0); GEMM_PIECE(_ga, _gb, _kk, slot2, (_g - 1) >> 1); __builtin_amdgcn_sched_barrier(0); } \
                } \
            } while (0)
#define GEMM_SLOT_A(kt_) do { \
            if ((kt_) == 0) { if (first) asm volatile("s_waitcnt vmcnt(6) lgkmcnt(0)" ::: "memory"); else asm volatile("s_waitcnt lgkmcnt(0)" ::: "memory"); } \
            else if ((kt_) + 1 < nk || has_next) asm volatile("s_waitcnt vmcnt(6) lgkmcnt(0)" ::: "memory"); \
            else asm volatile("s_waitcnt vmcnt(0) lgkmcnt(0)" ::: "memory"); \
            __builtin_amdgcn_sched_barrier(0); __builtin_amdgcn_s_barrier(); __builtin_amdgcn_sched_barrier(0); \
            asm volatile("" ::: "memory"); \
        } while (0)
#define GEMM_MID_BAR() do { \
            asm volatile("s_waitcnt lgkmcnt(0)" ::: "memory"); \
            __builtin_amdgcn_sched_barrier(0); __builtin_amdgcn_s_barrier(); __builtin_amdgcn_sched_barrier(0); \
            asm volatile("" ::: "memory"); \
        } while (0)
#define GEMM_REST(kt_) do { \
            __builtin_amdgcn_sched_barrier(0); \
            const int slot2 = (cur == 0) ? 2 : cur - 1; \
            const bool _own = (kt_) + 2 < nk; \
            if (_own || has_next) { \
                const bf16_t* _ga = _own ? ga : ga2; const bf16_t* _gb = _own ? gb : gb2; const int _kk = _own ? (kt_) + 2 : (kt_) + 2 - nk; \
                GEMM_PIECE(_ga, _gb, _kk, slot2, 3); GEMM_PIECE(_ga, _gb, _kk, slot2, 4); GEMM_PIECE(_ga, _gb, _kk, slot2, 5); } \
            __builtin_amdgcn_sched_barrier(0); \
        } while (0)
        if (half == 0) {
            for (int kt = 0; kt < nk; ++kt) {
                GEMM_SLOT_A(kt);
                const char* sa = lds + cur * 49152;
                const char* sb = sa + 32768;
                GEMM_READ();
                GEMM_REST(kt);
                GEMM_MID_BAR();
                GEMM_MMA_DMA(kt);
                cur = (cur == 2) ? 0 : cur + 1;
            }
        } else {
            for (int kt = 0; kt < nk; ++kt) {
                GEMM_SLOT_A(kt);
                if (kt > 0) GEMM_MMA_DMA(kt);
                else { const int slot2 = (cur == 0) ? 2 : cur - 1; GEMM_PIECE(ga, gb, 2, slot2, 0); GEMM_PIECE(ga, gb, 2, slot2, 1); GEMM_PIECE(ga, gb, 2, slot2, 2); }
                GEMM_MID_BAR();
                const char* sa = lds + cur * 49152;
                const char* sb = sa + 32768;
                GEMM_READ();
                GEMM_REST(kt);
                cur = (cur == 2) ? 0 : cur + 1;
            }
            asm volatile("s_waitcnt lgkmcnt(0)" ::: "memory");
            GEMM_MMA();
        }
#undef GEMM_REST
#undef GEMM_SLOT_A
#undef GEMM_MID_BAR
        if (has_next) asm volatile("s_waitcnt vmcnt(6)" ::: "memory");
        first = false;
#undef GEMM_READ
#undef GEMM_MMA
#undef GEMM_MMA_DMA
        const int mbase = m0 + wr * 64 + lr;
        const int nbase = n0 + wc * 64 + g * 4;
        if (EPI == EPI_F32) {
            bf16_t* Y = (bf16_t*)(p.ws + OFF_Y);
#pragma unroll
            for (int mt = 0; mt < 4; ++mt)
#pragma unroll
                for (int np = 0; np < 2; ++np) {
                    const f32x4 v0 = acc[mt][2 * np], v1 = acc[mt][2 * np + 1];
                    u32x2 a, b; a[0] = pack2(v0[0], v0[1]); a[1] = pack2(v0[2], v0[3]); b[0] = pack2(v1[0], v1[1]); b[1] = pack2(v1[2], v1[3]);
                    store_pair16(Y + (size_t)(mbase + mt * 16) * N + n0 + wc * 64 + np * 32, a, b, g);
                }
        } else if (EPI == EPI_GU) {
            bf16_t* U = (bf16_t*)(p.ws + OFF_U);
#pragma unroll
            for (int mt = 0; mt < 4; ++mt) {
                u32x2 o[2];
#pragma unroll
                for (int nt = 0; nt < 2; ++nt) {
                    const f32x4 gt = acc[mt][nt], up = acc[mt][nt + 2];
                    o[nt][0] = pack2(silu_f(gt[0]) * up[0], silu_f(gt[1]) * up[1]);
                    o[nt][1] = pack2(silu_f(gt[2]) * up[2], silu_f(gt[3]) * up[3]);
                }
                store_pair16(U + (size_t)(mbase + mt * 16) * DFF + pn * 64 + wc * 32, o[0], o[1], g);
            }
        } else {
            const int ncol0 = n0 + wc * 64;
            int sec, cofs, pitch;
            if (EPI == EPI_QKV_DIFF) { sec = ncol0 >> 10; cofs = ncol0 & 1023; pitch = 1024; }
            else { sec = ncol0 < 1024 ? 0 : (ncol0 < 1280 ? 1 : 2); cofs = sec == 0 ? ncol0 : (sec == 1 ? ncol0 - 1024 : ncol0 - 1280); pitch = sec == 0 ? 1024 : 256; }
            const bool latent = m0 >= NPROMPT;
            if (latent && sec < 2) {
                const float* rt = (const float*)(p.ws + OFF_ROPE);
#pragma unroll
                for (int mt = 0; mt < 4; ++mt) {
                    const int tl = (mbase + mt * 16 - NPROMPT) & 2047;
                    const int prow = tl >> 6, pcol = tl & 63;
                    const f32x4 r0 = *(const f32x4*)(rt + (prow * 16 + g * 4) * 2), r1 = *(const f32x4*)(rt + (prow * 16 + g * 4) * 2 + 4);
                    const f32x4 c0 = *(const f32x4*)(rt + (pcol * 16 + g * 4) * 2), c1 = *(const f32x4*)(rt + (pcol * 16 + g * 4) * 2 + 4);
                    const float cr[4] = {r0[0], r0[2], r1[0], r1[2]}, sr[4] = {r0[1], r0[3], r1[1], r1[3]};
                    const float cc[4] = {c0[0], c0[2], c1[0], c1[2]}, sc[4] = {c0[1], c0[3], c1[1], c1[3]};
#pragma unroll
                    for (int r = 0; r < 4; ++r) {
                        const float x1 = acc[mt][0][r], x2 = acc[mt][1][r], x3 = acc[mt][2][r], x4 = acc[mt][3][r];
                        acc[mt][0][r] = x1 * cr[r] - x2 * sr[r];
                        acc[mt][1][r] = x2 * cr[r] + x1 * sr[r];
                        acc[mt][2][r] = x3 * cc[r] - x4 * sc[r];
                        acc[mt][3][r] = x4 * cc[r] + x3 * sc[r];
                    }
                }
            }
            bf16_t* dstb = (bf16_t*)(p.ws + (sec == 0 ? OFF_Q : (sec == 1 ? OFF_K : OFF_V)));
            float* dstf = nullptr;
            if (!latent && sec > 0) {
                if (EPI == EPI_QKV_DIFF) dstf = p.out + (sec == 1 ? OUT_NDK : OUT_NDV);
                else dstf = p.out + (sec == 1 ? OUT_NSK : OUT_NSV);
            }
#pragma unroll
            for (int mt = 0; mt < 4; ++mt) {
                u32x2 o[4];
#pragma unroll
                for (int nt = 0; nt < 4; ++nt) {
                    const size_t idx = (size_t)(mbase + mt * 16) * pitch + cofs + g * 4 + nt * 16;
                    const f32x4 v = acc[mt][nt];
                    const f32x4 vs = (sec == 0) ? v * SC : v;
                    o[nt][0] = pack2(vs[0], vs[1]); o[nt][1] = pack2(vs[2], vs[3]);
                    if (dstf) *(f32x4*)(dstf + idx) = v;
                }
                bf16_t* rowp = dstb + (size_t)(mbase + mt * 16) * pitch + cofs;
                store_pair16(rowp, o[0], o[1], g);
                store_pair16(rowp + 32, o[2], o[3], g);
            }
        }
    }
}

#undef GEMM_STAGE
template <bool DIFF>
__device__ void attn_phase(const Params& p, char* lds) {
    constexpr int DV = DIFF ? 128 : 64, MT = DV / 16;
    constexpr int KBYTES = DIFF ? 16384 : 8192, VPITCH = DV * 2 + 32, BUFB = KBYTES + 64 * VPITCH;
    constexpr int NCH = DIFF ? 2 : 1, KSTEP = DIFF ? 32 : 64, PITCH = DIFF ? 1024 : 256;
    static_assert(2 * BUFB <= LDS_MAIN, "lds");
    const int tid = threadIdx.x, lane = tid & 63, w = tid >> 6, sub = w & 1, qg = w >> 1, lr = lane & 15, g = lane >> 4;
    const bf16_t* qbuf = (const bf16_t*)(p.ws + OFF_Q);
    const bf16_t* kbuf = (const bf16_t*)(p.ws + OFF_K);
    const bf16_t* vbuf = (const bf16_t*)(p.ws + OFF_V);
    bf16_t* obuf = (bf16_t*)(p.ws + OFF_O);
    float lam = 0.f;
    if (DIFF) {
        const float* dl = p.diff_lambda;
        const float a = wave_sum(dl[lane] * dl[64 + lane]), b = wave_sum(dl[128 + lane] * dl[192 + lane]);
        lam = __expf(a) - __expf(b) + 0.2f;
    }
    const int skey = DIFF ? (tid >> 4) : (tid >> 3), sch = DIFF ? (tid & 15) : (tid & 7);
    const int k_st = DIFF ? ((sch >> 3) * 8192 + skey * 128 + (((sch & 7) ^ ((skey >> 1) & 7)) << 4)) : (skey * 128 + ((sch ^ ((skey >> 1) & 7)) << 4));
    const int v_st = KBYTES + skey * VPITCH + sch * 16;
    const int g_off = skey * PITCH + sch * 8;

    const bool bg_first = (__popc(blockIdx.x) & 1) != 0;
    if (DIFF && bg_first) deferred_transposes(p, lds);
    for (int u = blockIdx.x; u < 512; u += gridDim.x) {
        int qtok0, n0t, t_lo, t_hi, vhead, qpos0 = 0;
        bool band = false;
        const bf16_t *K0 = nullptr, *V0 = nullptr, *K1, *V1;
        float m_init = 0.f, l_init = 0.f;
        if (DIFF) {
            int b, h, qb;
            if (u < 256) {
                const int xcd = u & 7, slot = u >> 3, bh = xcd * 2 + (slot >> 4);
                qb = slot & 15; b = bh >> 3; h = bh & 7;
                qtok0 = NPROMPT + b * 2048 + qb * 128;
                K0 = (const bf16_t*)(p.ws + OFF_CKD) + (size_t)(b * 512) * 1024 + h * 128;
                V0 = (const bf16_t*)(p.ws + OFF_CVD) + (size_t)(b * 512) * 1024 + h * 128;
                n0t = 8;
                K1 = kbuf + (size_t)(NPROMPT + b * 2048) * 1024 + h * 128;
                V1 = vbuf + (size_t)(NPROMPT + b * 2048) * 1024 + h * 128;
                t_lo = 0; t_hi = 32;
            } else {
                const int v = u - 256;
                b = v >> 4; h = (v >> 1) & 7; qb = v & 1;
                qtok0 = b * 256 + qb * 128;
                n0t = 0;
                K1 = kbuf + (size_t)(b * 256) * 1024 + h * 128;
                V1 = vbuf + (size_t)(b * 256) * 1024 + h * 128;
                t_lo = 0; t_hi = 4;
            }
            vhead = h * 2 + sub;
        } else {
            int b, kv, hp, qb;
            if (u < 256) {
                const int xcd = u & 7, slot = u >> 3;
                b = xcd >> 2; kv = xcd & 3; hp = slot >> 4; qb = slot & 15;
                qtok0 = NPROMPT + b * 2048 + qb * 128;
                K0 = (const bf16_t*)(p.ws + OFF_CKS) + (size_t)(b * 512) * 256 + kv * 64;
                V0 = (const bf16_t*)(p.ws + OFF_CVS) + (size_t)(b * 512) * 256 + kv * 64;
                n0t = 8;
                K1 = kbuf + (size_t)(NPROMPT + b * 2048) * 256 + kv * 64;
                V1 = vbuf + (size_t)(NPROMPT + b * 2048) * 256 + kv * 64;
                t_lo = 2 * qb - 2 < 0 ? 0 : 2 * qb - 2; t_hi = 2 * qb + 4 > 32 ? 32 : 2 * qb + 4;
                band = true; qpos0 = qb * 128;
            } else {
                const int v = u - 256;
                b = v >> 4; kv = (v >> 2) & 3; hp = (v >> 1) & 1; qb = v & 1;
                qtok0 = b * 256 + qb * 128;
                n0t = 0;
                K1 = kbuf + (size_t)(b * 256) * 256 + kv * 64;
                V1 = vbuf + (size_t)(b * 256) * 256 + kv * 64;
                t_lo = 0; t_hi = 4;
            }
            vhead = kv * 4 + hp * 2 + sub;
            m_init = p.swa_sink[vhead] * LOG2E;
            l_init = (g == 0) ? 1.f : 0.f;
        }
        const int ntile = n0t + (t_hi - t_lo);
        bf16x8 qf[2][2];
#pragma unroll
        for (int nt = 0; nt < 2; ++nt)
#pragma unroll
            for (int ks = 0; ks < 2; ++ks)
                qf[nt][ks] = *(const bf16x8*)(qbuf + (size_t)(qtok0 + qg * 32 + nt * 16 + lr) * 1024 + vhead * 64 + ks * 32 + g * 8);
        f32x4 O[MT][2];
#pragma unroll
        for (int i = 0; i < MT; ++i) { O[i][0] = (f32x4){0.f, 0.f, 0.f, 0.f}; O[i][1] = (f32x4){0.f, 0.f, 0.f, 0.f}; }
        float mrun[2] = {m_init, m_init};
        f32x4 Lacc[2] = {(f32x4){l_init, 0.f, 0.f, 0.f}, (f32x4){l_init, 0.f, 0.f, 0.f}};
        const short one_bf = (lr == 0) ? (short)0x3F80 : (short)0;
        const bf16x8 vones = {one_bf, one_bf, one_bf, one_bf, one_bf, one_bf, one_bf, one_bf};

        u32x4 rk[NCH], rv[NCH];
        {
            const bf16_t* kp = (n0t > 0) ? K0 : K1 + (size_t)t_lo * 64 * PITCH;
            const bf16_t* vp = (n0t > 0) ? V0 : V1 + (size_t)t_lo * 64 * PITCH;
#pragma unroll
            for (int c = 0; c < NCH; ++c) { rk[c] = *(const u32x4*)(kp + g_off + c * KSTEP * PITCH); rv[c] = *(const u32x4*)(vp + g_off + c * KSTEP * PITCH); }
#pragma unroll
            for (int c = 0; c < NCH; ++c) { *(u32x4*)(lds + k_st + c * KSTEP * 128) = rk[c]; *(u32x4*)(lds + v_st + c * KSTEP * VPITCH) = rv[c]; }
        }
        __syncthreads();
        for (int i = 0; i < ntile; ++i) {
            const bool more = i + 1 < ntile;
            if (more) {
                const int j = i + 1;
                const bf16_t* kp = (j < n0t) ? K0 + (size_t)j * 64 * PITCH : K1 + (size_t)(t_lo + j - n0t) * 64 * PITCH;
                const bf16_t* vp = (j < n0t) ? V0 + (size_t)j * 64 * PITCH : V1 + (size_t)(t_lo + j - n0t) * 64 * PITCH;
#pragma unroll
                for (int c = 0; c < NCH; ++c) { rk[c] = *(const u32x4*)(kp + g_off + c * KSTEP * PITCH); rv[c] = *(const u32x4*)(vp + g_off + c * KSTEP * PITCH); }
            }
            __builtin_amdgcn_sched_barrier(0);
            const char* buf = lds + (i & 1) * BUFB;
            const char* kb = buf + (DIFF ? sub * 8192 : 0);
            const char* vb = buf + KBYTES;
            f32x4 S[4][2];
            const f32x4 cin0 = {-mrun[0], -mrun[0], -mrun[0], -mrun[0]}, cin1 = {-mrun[1], -mrun[1], -mrun[1], -mrun[1]};
#pragma unroll
            for (int kt = 0; kt < 4; ++kt) {
                const bf16x8 kf = *(const bf16x8*)(kb + (kt * 16 + lr) * 128 + ((g ^ (lr >> 1)) << 4));
                S[kt][0] = MFMA16(kf, qf[0][0], cin0);
                S[kt][1] = MFMA16(kf, qf[1][0], cin1);
            }
#pragma unroll
            for (int kt = 0; kt < 4; ++kt) {
                const bf16x8 kf = *(const bf16x8*)(kb + (kt * 16 + lr) * 128 + (((4 + g) ^ (lr >> 1)) << 4));
                S[kt][0] = MFMA16(kf, qf[0][1], S[kt][0]);
                S[kt][1] = MFMA16(kf, qf[1][1], S[kt][1]);
            }
            const bool domask = band && i >= n0t && (unsigned)((t_lo + i - n0t) - (qpos0 >> 6)) >= 2u;
            const int kpos0 = (t_lo + i - n0t) * 64 + g * 4;
#pragma unroll
            for (int nt = 0; nt < 2; ++nt) {
                const int qpos = qpos0 + qg * 32 + nt * 16 + lr;
                float mx = -3.0e38f;
                if (domask) {
                    const int d0 = qpos - kpos0;
                    if ((t_lo + i - n0t) < (qpos0 >> 6)) {
                        const int thr = d0 - 128;
#pragma unroll
                        for (int kt = 0; kt < 4; ++kt)
#pragma unroll
                            for (int r = 0; r < 4; ++r) if (kt * 16 + r < thr) S[kt][nt][r] = -1e30f;
                    } else {
                        const int thr = d0 + 128;
#pragma unroll
                        for (int kt = 0; kt < 4; ++kt)
#pragma unroll
                            for (int r = 0; r < 4; ++r) if (kt * 16 + r > thr) S[kt][nt][r] = -1e30f;
                    }
                }
#pragma unroll
                for (int kt = 0; kt < 4; ++kt)
#pragma unroll
                    for (int r = 0; r < 4; ++r) mx = fmaxf(mx, S[kt][nt][r]);
                if (__builtin_amdgcn_ballot_w64((mx > 8.f) || (DIFF && i == 0)) != 0ull) {
                    mx = rows_max(mx);
                    const bool raise = (mx > 8.f) || (DIFF && i == 0);
                    const float delta = raise ? fmaxf(mx, -100.f) : 0.f;
                    const float alpha = __builtin_amdgcn_exp2f(-delta);
                    mrun[nt] += delta;
                    Lacc[nt] = Lacc[nt] * alpha;
#pragma unroll
                    for (int mt = 0; mt < MT; ++mt) O[mt][nt] = O[mt][nt] * alpha;
#pragma unroll
                    for (int kt = 0; kt < 4; ++kt) S[kt][nt] = S[kt][nt] - delta;
                }
#pragma unroll
                for (int kt = 0; kt < 4; ++kt)
#pragma unroll
                    for (int r = 0; r < 4; ++r) S[kt][nt][r] = __builtin_amdgcn_exp2f(S[kt][nt][r]);
            }
#pragma unroll
            for (int ks2 = 0; ks2 < 2; ++ks2) {
                bf16x8 pf[2];
#pragma unroll
                for (int nt = 0; nt < 2; ++nt) {
                    u32x4 pk;
                    pk[0] = pack2(S[2 * ks2][nt][0], S[2 * ks2][nt][1]); pk[1] = pack2(S[2 * ks2][nt][2], S[2 * ks2][nt][3]);
                    pk[2] = pack2(S[2 * ks2 + 1][nt][0], S[2 * ks2 + 1][nt][1]); pk[3] = pack2(S[2 * ks2 + 1][nt][2], S[2 * ks2 + 1][nt][3]);
                    pf[nt] = __builtin_bit_cast(bf16x8, pk);
                    Lacc[nt] = MFMA16(vones, pf[nt], Lacc[nt]);
                }
                const char* vrow = vb + (ks2 * 32 + g * 4 + (lr >> 2)) * VPITCH + (lr & 3) * 8;
#pragma unroll
                for (int mt = 0; mt < MT; ++mt) {
                    const s16x4 v0 = __builtin_amdgcn_ds_read_tr16_b64_v4i16((s16x4 __attribute__((address_space(3)))*)(vrow + mt * 32));
                    const s16x4 v1 = __builtin_amdgcn_ds_read_tr16_b64_v4i16((s16x4 __attribute__((address_space(3)))*)(vrow + mt * 32 + 16 * VPITCH));
                    const bf16x8 vf = __builtin_shufflevector(v0, v1, 0, 1, 2, 3, 4, 5, 6, 7);
                    O[mt][0] = MFMA16(vf, pf[0], O[mt][0]);
                    O[mt][1] = MFMA16(vf, pf[1], O[mt][1]);
                }
            }
            if (more) {
                char* nb = lds + ((i + 1) & 1) * BUFB;
#pragma unroll
                for (int c = 0; c < NCH; ++c) { *(u32x4*)(nb + k_st + c * KSTEP * 128) = rk[c]; *(u32x4*)(nb + v_st + c * KSTEP * VPITCH) = rv[c]; }
            }
            __syncthreads();
        }
#pragma unroll
        for (int nt = 0; nt < 2; ++nt) {
            const float l = rows_sum(Lacc[nt][0]);
            const float inv = __builtin_amdgcn_rcpf(l);
#pragma unroll
            for (int mt = 0; mt < MT; ++mt) O[mt][nt] = O[mt][nt] * inv;
        }
        if (DIFF) {
            float* ex = (float*)lds;
            if (sub == 1) {
#pragma unroll
                for (int nt = 0; nt < 2; ++nt)
#pragma unroll
                    for (int mt = 0; mt < MT; ++mt)
#pragma unroll
                        for (int r = 0; r < 4; ++r) ex[((qg * 2 + nt) * 32 + mt * 4 + r) * 64 + lane] = O[mt][nt][r];
            }
            __syncthreads();
            if (sub == 0) {
                const float* gs = p.diff_subln_g;
                const int h = vhead >> 1;
#pragma unroll
                for (int nt = 0; nt < 2; ++nt) {
                    float ss = 0.f;
#pragma unroll
                    for (int mt = 0; mt < MT; ++mt)
#pragma unroll
                        for (int r = 0; r < 4; ++r) {
                            const float d = O[mt][nt][r] - lam * ex[((qg * 2 + nt) * 32 + mt * 4 + r) * 64 + lane];
                            O[mt][nt][r] = d;
                            ss += d * d;
                        }
                    ss = rows_sum(ss);
                    const float rstd = rsqrtf(ss * (1.f / 128.f) + EPS) * 0.8f;
                    bf16_t* orow = obuf + (size_t)(qtok0 + qg * 32 + nt * 16 + lr) * 1024 + h * 128;
#pragma unroll
                    for (int mp = 0; mp < MT / 2; ++mp) {
                        u32x2 o[2];
#pragma unroll
                        for (int e = 0; e < 2; ++e) {
                            const int mt = 2 * mp + e;
                            const f32x4 gg = *(const f32x4*)(gs + mt * 16 + g * 4);
                            const f32x4 v = O[mt][nt] * rstd * gg;
                            o[e][0] = pack2(v[0], v[1]); o[e][1] = pack2(v[2], v[3]);
                        }
                        store_pair16(orow + mp * 32, o[0], o[1], g);
                    }
                }
            }
            __syncthreads();
        } else {
#pragma unroll
            for (int nt = 0; nt < 2; ++nt) {
                bf16_t* orow = obuf + (size_t)(qtok0 + qg * 32 + nt * 16 + lr) * 1024 + vhead * 64;
#pragma unroll
                for (int mp = 0; mp < MT / 2; ++mp) {
                    const f32x4 v0 = O[2 * mp][nt], v1 = O[2 * mp + 1][nt];
                    u32x2 a, b; a[0] = pack2(v0[0], v0[1]); a[1] = pack2(v0[2], v0[3]); b[0] = pack2(v1[0], v1[1]); b[1] = pack2(v1[2], v1[3]);
                    store_pair16(orow + mp * 32, a, b, g);
                }
            }
        }
    }
    if (DIFF && !bg_first) deferred_transposes(p, lds);
}

__global__ void __launch_bounds__(512, 2) mega(Params p) {
    extern __shared__ __attribute__((aligned(16))) char lds[];
    cg::grid_group grid = cg::this_grid();
    if (p.ws == nullptr) grid.sync();
    volatile LAS unsigned* st = (volatile LAS unsigned*)(lds + LDS_MAIN);
    if (threadIdx.x == 0) { st[0] = 0u; st[1] = 0u; st[2] = 0u; st[3] = 0u; }
    __syncthreads();
    const XcdBarrier xb = xcd_barrier_post((unsigned*)(p.ws + OFF_BAR), st);
    const bf16_t* hbuf = (const bf16_t*)(p.ws + OFF_H);
    const bf16_t* obuf = (const bf16_t*)(p.ws + OFF_O);
    const bf16_t* ubuf = (const bf16_t*)(p.ws + OFF_U);
    prepass(p, lds);
    xcd_barrier(xb);
    rowphase<0>(p, 0);
    xcd_barrier(xb);
    gemm_phase<EPI_QKV_DIFF>(p, hbuf, (const bf16_t*)(p.ws + OFF_WQKV0), 3072, 1024, lds);
    xcd_barrier(xb);
    attn_phase<true>(p, lds);
    xcd_barrier(xb);
    gemm_phase<EPI_F32>(p, obuf, (const bf16_t*)(p.ws + OFF_WO0), 1024, 1024, lds);
    xcd_barrier(xb);
    rowphase<1>(p, 0);
    xcd_barrier(xb);
    gemm_phase<EPI_GU>(p, hbuf, (const bf16_t*)(p.ws + OFF_WGU0), 5632, 1024, lds);
    xcd_barrier(xb);
    gemm_phase<EPI_F32>(p, ubuf, (const bf16_t*)(p.ws + OFF_WD0), 1024, 2816, lds);
    xcd_barrier(xb);
    rowphase<2>(p, 0);
    xcd_barrier(xb);
    gemm_phase<EPI_QKV_SWA>(p, hbuf, (const bf16_t*)(p.ws + OFF_WQKV1), 1536, 1024, lds);
    xcd_barrier(xb);
    attn_phase<false>(p, lds);
    xcd_barrier(xb);
    gemm_phase<EPI_F32>(p, obuf, (const bf16_t*)(p.ws + OFF_WO1), 1024, 1024, lds);
    xcd_barrier(xb);
    rowphase<1>(p, 1);
    xcd_barrier(xb);
    gemm_phase<EPI_GU>(p, hbuf, (const bf16_t*)(p.ws + OFF_WGU1), 5632, 1024, lds);
    xcd_barrier(xb);
    gemm_phase<EPI_F32>(p, ubuf, (const bf16_t*)(p.ws + OFF_WD1), 1024, 2816, lds);
    xcd_barrier(xb);
    rowphase<2>(p, 1);
}

extern "C" void kernel_launch(void* const* d_in, const int* in_sizes, int n_in, void* d_out, int out_size, void* d_ws, size_t ws_size, hipStream_t stream) {
    static int grid_blocks = 0;
    if (grid_blocks == 0) {
        if (n_in != 21 || ws_size < WS_END) { fprintf(stderr, "kernel_launch: unexpected inputs (n_in %d, ws %zu < %zu)\n", n_in, ws_size, (size_t)WS_END); grid_blocks = -1; return; }
        int dev = 0, cus = 0, per_cu = 0;
        (void)hipGetDevice(&dev);
        (void)hipDeviceGetAttribute(&cus, hipDeviceAttributeMultiprocessorCount, dev);
        if (hipFuncSetAttribute((const void*)mega, hipFuncAttributeMaxDynamicSharedMemorySize, LDS_BYTES) != hipSuccess) { fprintf(stderr, "kernel_launch: hipFuncSetAttribute failed\n"); grid_blocks = -1; return; }
        if (hipOccupancyMaxActiveBlocksPerMultiprocessor(&per_cu, (const void*)mega, NTHR, LDS_BYTES) != hipSuccess || per_cu < 1) { fprintf(stderr, "kernel_launch: occupancy query failed (%d)\n", per_cu); grid_blocks = -1; return; }
        if (per_cu > 1) per_cu = 1;
        grid_blocks = cus * per_cu;
        fprintf(stderr, "kernel_launch: %d CUs x %d = %d workgroups\n", cus, per_cu, grid_blocks);
    }
    if (grid_blocks < 0) return;
    if (hipMemsetAsync((char*)d_ws + OFF_BAR, 0, XCD_BAR_WORDS * 4, stream) != hipSuccess) { fprintf(stderr, "kernel_launch: memset failed\n"); return; }
    Params p{};
    const float** pp = (const float**)&p;
    for (int i = 0; i < 21; ++i) pp[i] = (const float*)d_in[i];
    p.out = (float*)d_out;
    p.ws = (char*)d_ws;
    void* args[] = {&p};
    hipError_t e = hipLaunchCooperativeKernel((const void*)mega, dim3(grid_blocks), dim3(NTHR), args, LDS_BYTES, stream);
    if (e != hipSuccess) fprintf(stderr, "cooperative launch failed: %s (grid %d)\n", hipGetErrorString(e), grid_blocks);
}
```
